# Optimizing an MI355X kernel written in HIP

```python
import math
import jax, jax.numpy as jnp
from jax import lax
import numpy as np

D_MODEL = 2048
BATCH = 2
SEQ = 4096
DEPTH = 2

HEAD_DIM = 128
DIL_HEADS = 6
DIL_BRANCHES = ((128, 1), (512, 4), (2048, 16))
DIL_BLOCK = 64
DIFF_HEADS = 4
DIFF_QK_DIM = HEAD_DIM // 2
DIFF_BLOCK = 128
SWA_Q_HEADS = 6
SWA_KV_HEADS = 2
SWA_RADIUS = 128
SWA_BLOCK = 128
D_FF = 5504

N_ALIBI_HEADS = SWA_Q_HEADS + DIL_HEADS + DIFF_HEADS
MIX_WIDTH = (DIL_HEADS + DIFF_HEADS + SWA_Q_HEADS) * HEAD_DIM
A_QKV = DIL_HEADS * HEAD_DIM
B_QK = DIFF_HEADS * 2 * DIFF_QK_DIM
B_V = DIFF_HEADS * HEAD_DIM
C_Q = SWA_Q_HEADS * HEAD_DIM
C_KV = SWA_KV_HEADS * HEAD_DIM
IN_SPLITS = (A_QKV, A_QKV, A_QKV, B_QK, B_QK, B_V, C_Q, C_KV, C_KV)
IN_WIDTH = sum(IN_SPLITS)
RMS_EPS = 1e-6
NEG = -1e30

kernel_name = "hybrid_dilated_diff_swa_macaron_encoder"


def rms_norm(x, g):
    xf = x.astype(jnp.float32)
    y = xf * lax.rsqrt(jnp.mean(xf * xf, axis=-1, keepdims=True) + RMS_EPS)
    return (y * g.astype(jnp.float32)).astype(x.dtype)


def swiglu(h, w_gate, w_up, w_down):
    return (jax.nn.silu(h @ w_gate) * (h @ w_up)) @ w_down


def alibi_slopes():
    n = N_ALIBI_HEADS
    return jnp.asarray(2.0 ** (-8.0 * np.arange(1, n + 1) / n), dtype=jnp.float32)


def banded_attention(q, k, v, radius, blk, slopes, dist_scale, sink=None):
    B, L, H, Dh = q.shape
    G = k.shape[2]
    R = H // G
    nb = -(-L // blk)
    Lp = nb * blk
    pad = Lp - L
    qb = jnp.pad(q, ((0, 0), (0, pad), (0, 0), (0, 0))).reshape(B, nb, blk, G, R, Dh)
    kp = jnp.pad(k, ((0, 0), (blk, pad + blk), (0, 0), (0, 0))).reshape(B, nb + 2, blk, G, Dh)
    vp = jnp.pad(v, ((0, 0), (blk, pad + blk), (0, 0), (0, 0))).reshape(B, nb + 2, blk, G, Dh)
    kb = jnp.concatenate([kp[:, :-2], kp[:, 1:-1], kp[:, 2:]], axis=2)
    vb = jnp.concatenate([vp[:, :-2], vp[:, 1:-1], vp[:, 2:]], axis=2)
    s = jnp.einsum('bnqgrd,bnkgd->bngrqk', qb, kb,
                   preferred_element_type=jnp.float32) * (Dh ** -0.5)
    a = jnp.arange(blk)
    c = jnp.arange(3 * blk)
    rel = c[None, :] - blk - a[:, None]
    kpos = jnp.arange(nb)[:, None] * blk + c[None, :] - blk
    valid = (jnp.abs(rel) <= radius)[None] & ((kpos >= 0) & (kpos < L))[:, None, :]
    bias = slopes.reshape(G, R)[:, :, None, None] * (dist_scale * jnp.abs(rel).astype(jnp.float32))
    s = jnp.where(valid[None, :, None, None], s - bias[None, None], NEG)
    m = jnp.max(s, axis=-1)
    if sink is not None:
        sink_b = sink.astype(jnp.float32).reshape(G, R)[None, None, :, :, None]
        m = jnp.maximum(m, sink_b)
    p = jnp.exp(s - m[..., None])
    den = jnp.sum(p, axis=-1)
    if sink is not None:
        den = den + jnp.exp(sink_b - m)
    o = jnp.einsum('bngrqk,bnkgd->bnqgrd', p.astype(v.dtype), vb,
                   preferred_element_type=jnp.float32)
    o = o / den.transpose(0, 1, 4, 2, 3)[..., None]
    lse = (m + jnp.log(den)).transpose(0, 1, 4, 2, 3)
    return o.reshape(B, Lp, H, Dh)[:, :L], lse.reshape(B, Lp, H)[:, :L]


def dilated_attention(q, k, v, slopes):
    B, S, H, Dh = q.shape
    outs, lses = [], []
    for window, dil in DIL_BRANCHES:
        L = S // dil

        def to_sub(t):
            return t.reshape(B, L, dil, H, Dh).transpose(0, 2, 1, 3, 4).reshape(B * dil, L, H, Dh)

        o, lse = banded_attention(to_sub(q), to_sub(k), to_sub(v), window // (2 * dil),
                                  DIL_BLOCK, slopes, float(dil))
        outs.append(o.reshape(B, dil, L, H, Dh).transpose(0, 2, 1, 3, 4).reshape(B, S, H, Dh))
        lses.append(lse.reshape(B, dil, L, H).transpose(0, 2, 1, 3).reshape(B, S, H))
    w = jax.nn.softmax(jnp.stack(lses, axis=0), axis=0)
    return jnp.einsum('ibsh,ibshd->bshd', w, jnp.stack(outs, axis=0))


def diff_attention(q, k, v, lam, slopes):
    B, S, H, _, Dq = q.shape
    Dv = v.shape[-1]
    nblk = S // DIFF_BLOCK
    qb = q.reshape(B, nblk, DIFF_BLOCK, H, 2, Dq).transpose(1, 0, 2, 3, 4, 5)
    kpos = jnp.arange(S)

    def block(args):
        qi, i = args
        s = jnp.einsum('bqhcd,bkhcd->bhcqk', qi, k,
                       preferred_element_type=jnp.float32) * (Dq ** -0.5)
        qpos = i * DIFF_BLOCK + jnp.arange(DIFF_BLOCK)
        dist = jnp.abs(qpos[:, None] - kpos[None, :]).astype(jnp.float32)
        s = s - slopes[None, :, None, None, None] * dist
        p = jax.nn.softmax(s, axis=-1)
        a = p[:, :, 0] - lam * p[:, :, 1]
        return jnp.einsum('bhqk,bkhd->bqhd', a.astype(v.dtype), v,
                          preferred_element_type=jnp.float32)

    o = lax.map(block, (qb, jnp.arange(nblk)))
    return o.transpose(1, 0, 2, 3, 4).reshape(B, S, H, Dv)


def mixing(h, w_in, w_out, lq1, lk1, lq2, lk2, subln_g, sink, lambda_init):
    B, S, _ = h.shape
    slopes = alibi_slopes()
    sl_c = slopes[:SWA_Q_HEADS]
    sl_a = slopes[SWA_Q_HEADS:SWA_Q_HEADS + DIL_HEADS]
    sl_b = slopes[SWA_Q_HEADS + DIL_HEADS:]
    idx = [int(i) for i in np.cumsum(IN_SPLITS)[:-1]]
    aq, ak, av, bq, bk, bv, cq, ck, cv = jnp.split(h @ w_in, idx, axis=-1)
    hd = lambda t, n: t.reshape(B, S, n, HEAD_DIM)
    out_a = dilated_attention(hd(aq, DIL_HEADS), hd(ak, DIL_HEADS), hd(av, DIL_HEADS), sl_a)
    lam = (jnp.exp(jnp.sum(lq1.astype(jnp.float32) * lk1.astype(jnp.float32)))
           - jnp.exp(jnp.sum(lq2.astype(jnp.float32) * lk2.astype(jnp.float32))) + lambda_init)
    out_b = diff_attention(bq.reshape(B, S, DIFF_HEADS, 2, DIFF_QK_DIM),
                           bk.reshape(B, S, DIFF_HEADS, 2, DIFF_QK_DIM),
                           hd(bv, DIFF_HEADS), lam, sl_b)
    out_b = rms_norm(out_b, subln_g) * (1.0 - lambda_init)
    out_c, _ = banded_attention(hd(cq, SWA_Q_HEADS), hd(ck, SWA_KV_HEADS), hd(cv, SWA_KV_HEADS),
                                SWA_RADIUS, SWA_BLOCK, sl_c, 1.0, sink)
    y = jnp.concatenate([out_a.reshape(B, S, -1), out_b.reshape(B, S, -1),
                         out_c.reshape(B, S, -1)], axis=-1).astype(h.dtype)
    return y @ w_out


def setup_inputs(seed: int = 0) -> dict:
    key = jax.random.key(seed)
    ks = jax.random.split(key, 20)
    f32 = jnp.float32

    def nrm(k, shape, scale):
        return jax.random.normal(k, shape, f32) * scale

    def gain(k, shape):
        return 1.0 + 0.05 * jax.random.normal(k, shape, f32)

    return {
        "x": nrm(ks[0], (BATCH, SEQ, D_MODEL), 1.0),
        "ffn1_norm": gain(ks[1], (DEPTH, D_MODEL)),
        "ffn1_w_gate": nrm(ks[2], (DEPTH, D_MODEL, D_FF), D_MODEL ** -0.5),
        "ffn1_w_up": nrm(ks[3], (DEPTH, D_MODEL, D_FF), D_MODEL ** -0.5),
        "ffn1_w_down": nrm(ks[4], (DEPTH, D_FF, D_MODEL), D_FF ** -0.5),
        "mix_norm": gain(ks[5], (DEPTH, D_MODEL)),
        "w_in": nrm(ks[6], (DEPTH, D_MODEL, IN_WIDTH), D_MODEL ** -0.5),
        "w_out": nrm(ks[7], (DEPTH, MIX_WIDTH, D_MODEL), MIX_WIDTH ** -0.5),
        "diff_lambda_q1": nrm(ks[8], (DEPTH, DIFF_QK_DIM), 0.1),
        "diff_lambda_k1": nrm(ks[9], (DEPTH, DIFF_QK_DIM), 0.1),
        "diff_lambda_q2": nrm(ks[10], (DEPTH, DIFF_QK_DIM), 0.1),
        "diff_lambda_k2": nrm(ks[11], (DEPTH, DIFF_QK_DIM), 0.1),
        "diff_subln": gain(ks[12], (DEPTH, HEAD_DIM)),
        "swa_sink": nrm(ks[13], (DEPTH, SWA_Q_HEADS), 1.0),
        "ffn2_norm": gain(ks[14], (DEPTH, D_MODEL)),
        "ffn2_w_gate": nrm(ks[15], (DEPTH, D_MODEL, D_FF), D_MODEL ** -0.5),
        "ffn2_w_up": nrm(ks[16], (DEPTH, D_MODEL, D_FF), D_MODEL ** -0.5),
        "ffn2_w_down": nrm(ks[17], (DEPTH, D_FF, D_MODEL), D_FF ** -0.5),
        "final_norm": gain(ks[18], (D_MODEL,)),
    }


def reference(x, ffn1_norm, ffn1_w_gate, ffn1_w_up, ffn1_w_down, mix_norm, w_in, w_out,
              diff_lambda_q1, diff_lambda_k1, diff_lambda_q2, diff_lambda_k2, diff_subln,
              swa_sink, ffn2_norm, ffn2_w_gate, ffn2_w_up, ffn2_w_down, final_norm):
    for l in range(DEPTH):
        lambda_init = 0.8 - 0.6 * math.exp(-0.3 * l)
        h = rms_norm(x, ffn1_norm[l])
        x = x + 0.5 * swiglu(h, ffn1_w_gate[l], ffn1_w_up[l], ffn1_w_down[l])
        h = rms_norm(x, mix_norm[l])
        x = x + mixing(h, w_in[l], w_out[l], diff_lambda_q1[l], diff_lambda_k1[l],
                       diff_lambda_q2[l], diff_lambda_k2[l], diff_subln[l], swa_sink[l],
                       lambda_init)
        h = rms_norm(x, ffn2_norm[l])
        x = x + 0.5 * swiglu(h, ffn2_w_gate[l], ffn2_w_up[l], ffn2_w_down[l])
    return rms_norm(x, final_norm)
```

```cpp
#include <hip/hip_runtime.h>
#include <hip/hip_cooperative_groups.h>
#include <cstdio>
#include <cstdint>
namespace cg = cooperative_groups;

typedef unsigned short bf16_t;
typedef short bf16x8 __attribute__((ext_vector_type(8)));
typedef float f32x4 __attribute__((ext_vector_type(4)));
typedef float f32x16 __attribute__((ext_vector_type(16)));
typedef unsigned u32x4 __attribute__((ext_vector_type(4)));
#define LAS __attribute__((address_space(3)))

constexpr int BATCH = 2, SEQ = 4096, T = BATCH * SEQ, DM = 2048, DFF = 5504, NGU = 2 * DFF, INW = 5120, DEPTH = 2, HD = 128;
constexpr float RMS_EPS = 1e-6f;
constexpr int NWAVES = 8, NTHREADS = NWAVES * 64;
constexpr int LDS_BYTES = 147456;

constexpr int QA = 0, KA = 768, VA = 1536, QB_ = 2304, KB_ = 2816, VB_ = 3328, QC = 3840, KC = 4608, VC = 4864;
constexpr int YA = 0, YB = 768, YC = 1280;

constexpr size_t al256(size_t x) { return (x + 255) / 256 * 256; }
constexpr size_t WS_SS = 0;
constexpr size_t SZ_SS = (size_t)7 * T * 4;
constexpr size_t SZ_WGU = (size_t)NGU * DM * 2, SZ_WD = (size_t)DM * DFF * 2, SZ_WIN = (size_t)INW * DM * 2, SZ_WOUT = (size_t)DM * DM * 2;
constexpr size_t WS_BAR = al256(WS_SS + SZ_SS);
constexpr size_t WS_WGU = WS_BAR + 16384;
constexpr size_t WS_WD = WS_WGU + 4 * SZ_WGU;
constexpr size_t WS_WIN = WS_WD + 4 * SZ_WD;
constexpr size_t WS_WOUT = WS_WIN + 2 * SZ_WIN;
constexpr size_t WS_XB = WS_WOUT + 2 * SZ_WOUT;
constexpr size_t WS_ACT = WS_XB + (size_t)T * DM * 2;
constexpr size_t WS_QKV = WS_ACT;
constexpr size_t WS_Y = WS_ACT + (size_t)T * DFF * 2;
constexpr size_t WS_PART = WS_Y + (size_t)T * DM * 2;
constexpr size_t WS_LSE = WS_PART + (size_t)3 * T * 768 * 4;
constexpr size_t WS_END = WS_LSE + (size_t)3 * T * 6 * 4;
#ifndef PROBE_PRO
#define PROBE_PRO 0
#endif
#ifndef PROBE_SYNC
#define PROBE_SYNC 0
#endif
#ifndef PROBE_ATTN
#define PROBE_ATTN 0
#endif
#ifndef PROBE_GU
#define PROBE_GU 0
#endif
#ifndef MFMA_B
#define MFMA_B true
#endif
#ifndef MFMA_A
#define MFMA_A true
#endif
#ifndef MFMA_C
#define MFMA_C true
#endif

struct Args { const float* in[19]; float* out; unsigned char* ws; };

__device__ __forceinline__ unsigned f2bf(float f) { unsigned u = __float_as_uint(f); return (u + 0x7fffu + ((u >> 16) & 1u)) >> 16; }
__device__ __forceinline__ unsigned pk2(float lo, float hi) { return f2bf(lo) | (f2bf(hi) << 16); }
__device__ __forceinline__ float bf2f(unsigned b) { return __uint_as_float(b << 16); }
__device__ __forceinline__ int crow(int r, int hi) { return (r & 3) + 8 * (r >> 2) + 4 * hi; }
template <int M> __device__ __forceinline__ float xswz(float v) { return __uint_as_float((unsigned)__builtin_amdgcn_ds_swizzle((int)__float_as_uint(v), (M << 10) | 0x1f)); }
__device__ __forceinline__ float half_sum(float v) { auto rr = __builtin_amdgcn_permlane32_swap(__float_as_uint(v), __float_as_uint(v), false, false); return __uint_as_float(rr[0]) + __uint_as_float(rr[1]); }
__device__ __forceinline__ float half_max(float v) { auto rr = __builtin_amdgcn_permlane32_swap(__float_as_uint(v), __float_as_uint(v), false, false); return fmaxf(__uint_as_float(rr[0]), __uint_as_float(rr[1])); }
__device__ __forceinline__ float sum32(float v) { v += xswz<1>(v); v += xswz<2>(v); v += xswz<4>(v); v += xswz<8>(v); v += xswz<16>(v); return v; }
__device__ __forceinline__ float wave_sum(float v) { return half_sum(sum32(v)); }
__device__ __forceinline__ float wave_max(float v) { v = fmaxf(v, xswz<1>(v)); v = fmaxf(v, xswz<2>(v)); v = fmaxf(v, xswz<4>(v)); v = fmaxf(v, xswz<8>(v)); v = fmaxf(v, xswz<16>(v)); return half_max(v); }
__device__ __forceinline__ int lane_now() { int l; asm volatile("v_mbcnt_lo_u32_b32 %0, -1, 0\n\tv_mbcnt_hi_u32_b32 %0, -1, %0" : "=v"(l)); return l; }
#define LDS_WAIT() asm volatile("s_waitcnt lgkmcnt(0)" ::: "memory")
__device__ __forceinline__ int opaque_bid() { int b = blockIdx.x; asm volatile("" : "+s"(b)); return b; }
__device__ __forceinline__ int opaque_tid(int wv) { return wv * 64 + lane_now(); }

struct TItem { const float* W; const float* g; bf16_t* WT; int K, N, mode, r; };
__device__ __forceinline__ void titem_load(const TItem& t, int lane, float (&v)[64]) {
    const int nblk = t.N / 64, kb = t.r / nblk, nb = t.r % nblk, k0 = 64 * kb, n0 = 64 * nb;
    const float* src = t.W + (size_t)k0 * t.N + n0 + lane;
#pragma unroll
    for (int i = 0; i < 64; ++i) v[i] = __builtin_nontemporal_load(src + (size_t)i * t.N);
}
__device__ __forceinline__ void titem_store(const TItem& t, int lane, float (&v)[64], LAS unsigned char* scr) {
    const int nblk = t.N / 64, kb = t.r / nblk, nb = t.r % nblk, k0 = 64 * kb, n0 = 64 * nb;
    if (t.g) {
#pragma unroll
        for (int i = 0; i < 64; ++i) v[i] *= t.g[k0 + i];
    }
    LAS u32x4* wrow = (LAS u32x4*)(scr + lane * 144);
#pragma unroll
    for (int j = 0; j < 8; ++j) { u32x4 o; o.x = pk2(v[8 * j], v[8 * j + 1]); o.y = pk2(v[8 * j + 2], v[8 * j + 3]); o.z = pk2(v[8 * j + 4], v[8 * j + 5]); o.w = pk2(v[8 * j + 6], v[8 * j + 7]);
        wrow[j] = o; }
    LDS_WAIT();
    const int drow0 = (t.mode == 0 ? n0 : (n0 / 128) * 256 + (n0 % 128) + (t.mode == 2 ? 128 : 0));
    const int c = lane & 7, nn = lane >> 3;
#pragma unroll
    for (int j = 0; j < 8; ++j) { const int n = nn + 8 * j;
        const u32x4 o = *(const LAS u32x4*)(scr + n * 144 + c * 16);
        *(u32x4*)(t.WT + (size_t)(drow0 + n) * t.K + k0 + 8 * c) = o; }
    LDS_WAIT();
}

namespace pg8 {
#define PG8_LAS __attribute__((address_space(3)))
typedef unsigned short bf16_t;
typedef short bf16x8 __attribute__((ext_vector_type(8)));
typedef float f32x4 __attribute__((ext_vector_type(4)));
typedef unsigned u32x4 __attribute__((ext_vector_type(4)));
constexpr int BM = 256, BK = 64, HALF = 128, HTB = HALF * BK * 2  , STAGE_BYTES = 8 * HTB, NXCD = 8, WGM = 8;

__host__ __device__ __forceinline__ int lds_byte(int r, int c) { const int st = (r >> 4) * 2 + (c >> 5), rr = r & 15, cc = c & 31, ob = rr * 64 + cc * 2; return st * 1024 + (ob ^ (((ob >> 9) & 1) << 5)); }
__host__ __device__ __forceinline__ void stage_rc(int b, int& R, int& C) { const int st = b / 1024, sb = b % 1024, swz = sb ^ (((sb >> 9) & 1) << 5); R = (st >> 1) * 16 + swz / 64; C = (st & 1) * 32 + (swz % 64) / 2; }
__host__ __device__ __forceinline__ int perm32(int rho) { const int n = rho >> 4, i = rho & 15; return 8 * (i >> 2) + 4 * n + (i & 3); }

struct Unit { int pm, pn; };
struct Gemm { const bf16_t* A; const bf16_t* Bt; int M, N, K; };

struct StaticOrder {
    int nM, nN, nwg, G, c;
    __host__ __device__ void init(int M, int N, int G_, int c_) { nM = M / BM; nN = N / BM; nwg = nM * nN; G = G_; c = c_; }
    __host__ __device__ bool next(int i, Unit& u) const {
        const long L = (long)i * G + c; if (L >= nwg) return false;
        int wgid = (int)L; { const int q = nwg / NXCD, r = nwg % NXCD, xcd = wgid % NXCD, off = wgid / NXCD; wgid = (xcd < r ? xcd * (q + 1) : r * (q + 1) + (xcd - r) * q) + off; }
        const int nig = WGM * nN, gid = wgid / nig, fm = gid * WGM, gsz = (nM - fm) < WGM ? (nM - fm) : WGM;
        u.pm = fm + ((wgid % nig) % gsz); u.pn = (wgid % nig) / gsz; return true;
    }
    __device__ __forceinline__ void a_ready(const Unit&) const {}
    __device__ __forceinline__ void done(const Unit&) const {}
};

__device__ __forceinline__ unsigned cvt_pk_bf16(float lo, float hi) { unsigned r; asm volatile("v_cvt_pk_bf16_f32 %0, %1, %2" : "=v"(r) : "v"(lo), "v"(hi)); return r; }
__device__ __forceinline__ float rstd2048(const float* ss, int row) { return rsqrtf(ss[row] * (1.0f / 2048.0f) + 1e-6f); }
struct EpiGU {
    static constexpr bool PERM = true, AFTER_DRAIN = false;
    bf16_t* O; const float* ss;
    __device__ __forceinline__ void operator()(const f32x4 (&acc)[2][2][4][2], const Unit& u, int wr, int wc, int fr, int fq) const {
        const int row0 = u.pm * BM + wr * 64 + fr, col0 = u.pn * HALF + wc * 32 + 8 * fq;
#pragma unroll
        for (int ai = 0; ai < 2; ++ai)
#pragma unroll
            for (int m = 0; m < 4; ++m) {
                const int row = row0 + ai * HALF + m * 16; const float rs = rstd2048(ss, row);
                float o[8];
#pragma unroll
                for (int n = 0; n < 2; ++n)
#pragma unroll
                    for (int e = 0; e < 4; ++e) { const float g = acc[ai][0][m][n][e] * rs, uu = acc[ai][1][m][n][e] * rs;
                        o[4 * n + e] = g * __builtin_amdgcn_rcpf(1.0f + __expf(-g)) * uu; }
                u32x4 w; w.x = cvt_pk_bf16(o[0], o[1]); w.y = cvt_pk_bf16(o[2], o[3]); w.z = cvt_pk_bf16(o[4], o[5]); w.w = cvt_pk_bf16(o[6], o[7]);
                *(u32x4*)(O + (size_t)row * 5504 + col0) = w;
            }
    }
};
struct EpiRow {
    static constexpr bool PERM = true, AFTER_DRAIN = false;
    bf16_t* O; int ldc; const float* ss;
    __device__ __forceinline__ void operator()(const f32x4 (&acc)[2][2][4][2], const Unit& u, int wr, int wc, int fr, int fq) const {
        const int row0 = u.pm * BM + wr * 64 + fr, col0 = u.pn * BM + wc * 32 + 8 * fq;
#pragma unroll
        for (int ai = 0; ai < 2; ++ai)
#pragma unroll
            for (int m = 0; m < 4; ++m) {
                const int row = row0 + ai * HALF + m * 16; const float rs = rstd2048(ss, row);
#pragma unroll
                for (int bj = 0; bj < 2; ++bj) { const f32x4 v0 = acc[ai][bj][m][0] * rs, v1 = acc[ai][bj][m][1] * rs;
                    u32x4 w; w.x = cvt_pk_bf16(v0[0], v0[1]); w.y = cvt_pk_bf16(v0[2], v0[3]); w.z = cvt_pk_bf16(v1[0], v1[1]); w.w = cvt_pk_bf16(v1[2], v1[3]);
                    *(u32x4*)(O + (size_t)row * ldc + col0 + bj * HALF) = w; }
            }
    }
};
struct EpiResid {
    static constexpr bool PERM = true, AFTER_DRAIN = false;
    const float* xi; float* xo; bf16_t* xb; float* ssn; float alpha;
    __device__ __forceinline__ void operator()(const f32x4 (&acc)[2][2][4][2], const Unit& u, int wr, int wc, int fr, int fq) const {
        const int row0 = u.pm * BM + wr * 64 + fr, col0 = u.pn * BM + wc * 32 + 8 * fq;
#pragma unroll
        for (int ai = 0; ai < 2; ++ai)
#pragma unroll
            for (int m = 0; m < 4; ++m) {
                const int row = row0 + ai * HALF + m * 16; float s = 0.f;
#pragma unroll
                for (int bj = 0; bj < 2; ++bj) { const size_t off = (size_t)row * 2048 + col0 + bj * HALF;
                    const f32x4 v0 = *(const f32x4*)(xi + off) + acc[ai][bj][m][0] * alpha, v1 = *(const f32x4*)(xi + off + 4) + acc[ai][bj][m][1] * alpha;
                    *(f32x4*)(xo + off) = v0; *(f32x4*)(xo + off + 4) = v1;
                    u32x4 w; w.x = cvt_pk_bf16(v0[0], v0[1]); w.y = cvt_pk_bf16(v0[2], v0[3]); w.z = cvt_pk_bf16(v1[0], v1[1]); w.w = cvt_pk_bf16(v1[2], v1[3]);
                    *(u32x4*)(xb + off) = w;
                    s += (v0[0] * v0[0] + v0[1] * v0[1]) + (v0[2] * v0[2] + v0[3] * v0[3]) + (v1[0] * v1[0] + v1[1] * v1[1]) + (v1[2] * v1[2] + v1[3] * v1[3]); }
                s += xswz<16>(s); s = half_sum(s);
                if (fq == 0) atomicAdd(ssn + row, s);
            }
    }
};
template <class Epi, class Sched, bool ALIGN_EPI = false, bool SP2 = false>
__device__ __forceinline__ void gemm_phase(PG8_LAS unsigned char* lds, const Gemm g, const Sched& S, const Epi& E, int wv) {
    const int tid_ = wv * 64 + lane_now();
    const int tid = tid_, wid = __builtin_amdgcn_readfirstlane(tid >> 6), lane = tid & 63, wr = wid >> 2, wc = wid & 3, fr = lane & 15, fq = lane >> 4;
    const int K = g.K, nt = K / BK;
    unsigned voffA[2], voffB[2];
#pragma unroll
    for (int i = 0; i < 2; ++i) { int R, C; stage_rc(tid * 16 + i * 8192, R, C); const int Rb = Epi::PERM ? ((R & ~31) + perm32(R & 31)) : R;
        voffA[i] = (unsigned)(R * K + C) * 2u; voffB[i] = (unsigned)(Rb * K + C) * 2u; }
    const size_t kstep = (size_t)(BK * 2);
    const size_t hstep = (size_t)HALF * K * 2;
    const size_t tstep = 2 * hstep;
    const unsigned ldsw = (unsigned)wid * 1024u;
    const int aoff = lds_byte(wr * 64 + fr, fq * 8), boff = lds_byte(wc * 32 + fr, fq * 8);
#define PG8_SA(b, h) (((b) * 2 + (h)) * HTB)
#define PG8_SB(b, h) ((4 + (b) * 2 + (h)) * HTB)
#define PG8_STAGE(bufoff, gbase, voff) do { _Pragma("unroll") for (int _i = 0; _i < 2; ++_i) \
        __builtin_amdgcn_global_load_lds((const unsigned*)((const char*)(gbase) + (voff)[_i]), (PG8_LAS unsigned*)(lds + (bufoff) + ldsw + _i * 8192), 16, 0, 0); } while (0)
#define PG8_LDA(dst, b, h) do { _Pragma("unroll") for (int m = 0; m < 4; ++m) _Pragma("unroll") for (int k = 0; k < 2; ++k) dst[m][k] = *(const PG8_LAS bf16x8*)(lds + PG8_SA(b, h) + aoff + m * 2048 + k * 1024); } while (0)
#define PG8_LDB(dst, b, h) do { _Pragma("unroll") for (int n = 0; n < 2; ++n) _Pragma("unroll") for (int k = 0; k < 2; ++k) dst[n][k] = *(const PG8_LAS bf16x8*)(lds + PG8_SB(b, h) + boff + n * 2048 + k * 1024); } while (0)
#define PG8_MMA(ai, bj, At, Bt) do { __builtin_amdgcn_s_setprio(1); _Pragma("unroll") for (int m = 0; m < 4; ++m) _Pragma("unroll") for (int n = 0; n < 2; ++n) _Pragma("unroll") for (int k = 0; k < 2; ++k) \
        acc[ai][bj][m][n] = __builtin_amdgcn_mfma_f32_16x16x32_bf16(Bt[n][k], At[m][k], acc[ai][bj][m][n], 0, 0, 0); __builtin_amdgcn_s_setprio(0); } while (0)
#define PG8_WAIT_V(n) asm volatile("s_waitcnt vmcnt(" #n ")" ::: "memory")
#define PG8_WAIT_L(n) asm volatile("s_waitcnt lgkmcnt(" #n ")" ::: "memory")
#define PG8_BAR __builtin_amdgcn_s_barrier()
#define PG8_SCHED __builtin_amdgcn_sched_barrier(0)
    Unit cur, nxt; int ui = 0;
    if (!S.next(0, cur)) return;
    f32x4 acc[2][2][4][2];
#pragma unroll
    for (int a = 0; a < 2; ++a)
#pragma unroll
        for (int b = 0; b < 2; ++b)
#pragma unroll
            for (int m = 0; m < 4; ++m)
#pragma unroll
                for (int n = 0; n < 2; ++n) acc[a][b][m][n] = (f32x4){0.f, 0.f, 0.f, 0.f};
    bf16x8 At[4][2], B0[2][2], B1[2][2];
    const char* cA = (const char*)g.A + (size_t)cur.pm * tstep; const char* cB = (const char*)g.Bt + (size_t)cur.pn * tstep;
    S.a_ready(cur);
    if constexpr (SP2) {
        PG8_STAGE(PG8_SB(0, 0), cB, voffB); PG8_STAGE(PG8_SB(0, 1), cB + hstep, voffB); PG8_STAGE(PG8_SA(0, 0), cA, voffA); PG8_STAGE(PG8_SA(0, 1), cA + hstep, voffA);
        if (wr == 1) PG8_BAR;
        PG8_WAIT_V(2); PG8_BAR;
        PG8_STAGE(PG8_SB(1, 0), cB + kstep, voffB); PG8_STAGE(PG8_SA(1, 0), cA + kstep, voffA); PG8_STAGE(PG8_SB(1, 1), cB + hstep + kstep, voffB);
        PG8_WAIT_V(6); PG8_BAR;
    } else {
        PG8_STAGE(PG8_SB(0, 0), cB, voffB); PG8_STAGE(PG8_SA(0, 0), cA, voffA); PG8_STAGE(PG8_SB(0, 1), cB + hstep, voffB); PG8_STAGE(PG8_SA(0, 1), cA + hstep, voffA);
        if (wr == 1) PG8_BAR;
        PG8_WAIT_V(4); PG8_BAR;
        PG8_STAGE(PG8_SB(1, 0), cB + kstep, voffB); PG8_STAGE(PG8_SA(1, 0), cA + kstep, voffA); PG8_STAGE(PG8_SB(1, 1), cB + hstep + kstep, voffB);
        PG8_WAIT_V(6); PG8_BAR;
    }
    for (;;) {
        const bool has_next = S.next(ui + 1, nxt);
        const char* nA = has_next ? (const char*)g.A + (size_t)nxt.pm * tstep : cA; const char* nB = has_next ? (const char*)g.Bt + (size_t)nxt.pn * tstep : cB;
        for (int t = 0; t < nt; t += 2) {
            const bool last = (t == nt - 2);
            const char* a1 = cA + (size_t)(t + 1) * kstep;
            const char* a2 = last ? nA : cA + (size_t)(t + 2) * kstep; const char* b2 = last ? nB : cB + (size_t)(t + 2) * kstep;
            const char* a3 = a2 + kstep; const char* b3 = b2 + kstep;
            if (last && has_next) S.a_ready(nxt);
            if constexpr (SP2) {
            PG8_LDB(B0, 0, 0); PG8_LDB(B1, 0, 1); PG8_SCHED; PG8_LDA(At, 0, 0); PG8_STAGE(PG8_SA(1, 1), a1 + hstep, voffA);
            PG8_WAIT_V(8); PG8_WAIT_L(0); PG8_BAR; PG8_MMA(0, 0, At, B0); PG8_MMA(0, 1, At, B1); PG8_BAR; PG8_SCHED;
            PG8_LDA(At, 0, 1); PG8_STAGE(PG8_SB(0, 0), b2, voffB); PG8_STAGE(PG8_SB(0, 1), b2 + hstep, voffB); PG8_STAGE(PG8_SA(0, 0), a2, voffA);
            PG8_WAIT_V(8); PG8_WAIT_L(0); PG8_BAR; PG8_MMA(1, 0, At, B0); PG8_MMA(1, 1, At, B1); PG8_BAR; PG8_SCHED;
            PG8_LDB(B0, 1, 0); PG8_LDB(B1, 1, 1); PG8_SCHED; PG8_LDA(At, 1, 0); PG8_STAGE(PG8_SA(0, 1), a2 + hstep, voffA);
            PG8_WAIT_V(8); PG8_WAIT_L(0); PG8_BAR; PG8_MMA(0, 0, At, B0); PG8_MMA(0, 1, At, B1); PG8_BAR; PG8_SCHED;
            PG8_LDA(At, 1, 1); PG8_STAGE(PG8_SB(1, 0), b3, voffB); PG8_STAGE(PG8_SB(1, 1), b3 + hstep, voffB); PG8_STAGE(PG8_SA(1, 0), a3, voffA);
            PG8_WAIT_V(8); PG8_WAIT_L(0); PG8_BAR; PG8_MMA(1, 0, At, B0); PG8_MMA(1, 1, At, B1); PG8_BAR; PG8_SCHED;
            } else {
            PG8_LDB(B0, 0, 0); PG8_SCHED; PG8_LDA(At, 0, 0); PG8_STAGE(PG8_SA(1, 1), a1 + hstep, voffA);
            PG8_WAIT_L(8); PG8_BAR; PG8_WAIT_L(0); PG8_MMA(0, 0, At, B0); PG8_BAR; PG8_SCHED;
            PG8_LDB(B1, 0, 1); PG8_STAGE(PG8_SB(0, 0), b2, voffB);
            PG8_BAR; PG8_WAIT_L(0); PG8_MMA(0, 1, At, B1); PG8_BAR;
            PG8_LDA(At, 0, 1); PG8_STAGE(PG8_SA(0, 0), a2, voffA);
            PG8_BAR; PG8_WAIT_L(0); PG8_MMA(1, 0, At, B0); PG8_BAR; PG8_SCHED;
            PG8_STAGE(PG8_SB(0, 1), b2 + hstep, voffB);
            PG8_WAIT_V(6); PG8_BAR; PG8_MMA(1, 1, At, B1); PG8_BAR;
            PG8_LDB(B0, 1, 0); PG8_SCHED; PG8_LDA(At, 1, 0); PG8_STAGE(PG8_SA(0, 1), a2 + hstep, voffA);
            PG8_WAIT_L(8); PG8_BAR; PG8_WAIT_L(0); PG8_MMA(0, 0, At, B0); PG8_BAR; PG8_SCHED;
            PG8_LDB(B1, 1, 1); PG8_STAGE(PG8_SB(1, 0), b3, voffB);
            PG8_BAR; PG8_WAIT_L(0); PG8_MMA(0, 1, At, B1); PG8_BAR;
            PG8_LDA(At, 1, 1); PG8_STAGE(PG8_SA(1, 0), a3, voffA);
            PG8_BAR; PG8_WAIT_L(0); PG8_MMA(1, 0, At, B0); PG8_BAR; PG8_SCHED;
            PG8_STAGE(PG8_SB(1, 1), b3 + hstep, voffB);
            PG8_WAIT_V(6); PG8_BAR; PG8_MMA(1, 1, At, B1); PG8_BAR;
            }
        }
        if constexpr (ALIGN_EPI) { if (wr == 0) PG8_BAR; }
        if constexpr (!Epi::AFTER_DRAIN) { E(acc, cur, wr, wc, fr, fq); S.done(cur); }
        if (!has_next) break;
#pragma unroll
        for (int a = 0; a < 2; ++a)
#pragma unroll
            for (int b = 0; b < 2; ++b)
#pragma unroll
                for (int m = 0; m < 4; ++m)
#pragma unroll
                    for (int n = 0; n < 2; ++n) acc[a][b][m][n] = (f32x4){0.f, 0.f, 0.f, 0.f};
        cur = nxt; cA = nA; cB = nB; ++ui;
        if constexpr (ALIGN_EPI) { if (wr == 1) PG8_BAR; }
    }
    PG8_WAIT_V(0);
    if constexpr (!ALIGN_EPI) { if (wr == 0) PG8_BAR; }
    PG8_BAR;
    if constexpr (Epi::AFTER_DRAIN) { E.fused(acc, cur, wr, wc, fr, fq, lds, wid, lane); S.done(cur); }
#undef PG8_SA
#undef PG8_SB
#undef PG8_STAGE
#undef PG8_LDA
#undef PG8_LDB
#undef PG8_MMA
#undef PG8_WAIT_V
#undef PG8_WAIT_L
#undef PG8_BAR
#undef PG8_SCHED
}
}

__device__ __forceinline__ float rstd_of(const float* ss, int row) { return rsqrtf(ss[row] * (1.0f / DM) + RMS_EPS); }

struct Seg { int start, count, stride; };

template <int DQ>
__device__ __forceinline__ void attn_wave(const bf16_t* qrow, const bf16_t* kb, const bf16_t* vb, int t, float slope, float scale,
                                          Seg s0, Seg s1, Seg s2, int nseg, bool has_sink, float sink,
                                          LAS float* qs, LAS float* sc, int lane, float& o0, float& o1) {
    for (int d = lane; d < DQ; d += 64) qs[d] = bf2f(qrow[d]);
    LDS_WAIT();
    float m = -1e30f; int base = 0;
    for (int si = 0; si < nseg; ++si) {
        const Seg s = si == 0 ? s0 : (si == 1 ? s1 : s2);
        for (int i = lane; i < s.count; i += 64) {
            const int pos = s.start + i * s.stride;
            const bf16_t* kr = kb + (size_t)pos * INW;
            float dot = 0.f;
            for (int d = 0; d < DQ; d += 8) {
                const bf16x8 kv = *(const bf16x8*)(kr + d);
#pragma unroll
                for (int e = 0; e < 8; ++e) dot += qs[d + e] * bf2f((unsigned short)kv[e]);
            }
            const int dist = t > pos ? t - pos : pos - t;
            const float val = dot * scale - slope * (float)dist;
            sc[base + i] = val; m = fmaxf(m, val);
        }
        base += s.count;
    }
    m = wave_max(m);
    if (has_sink) m = fmaxf(m, sink);
    float l = 0.f;
    for (int i = lane; i < base; i += 64) { const float p = __expf(sc[i] - m); sc[i] = p; l += p; }
    l = wave_sum(l);
    if (has_sink) l += __expf(sink - m);
    LDS_WAIT();
    float a0 = 0.f, a1 = 0.f; int idx = 0;
    for (int si = 0; si < nseg; ++si) {
        const Seg s = si == 0 ? s0 : (si == 1 ? s1 : s2);
        for (int i = 0; i < s.count; ++i) {
            const int pos = s.start + i * s.stride;
            const float p = sc[idx + i];
            const unsigned v = *(const unsigned*)(vb + (size_t)pos * INW + 2 * lane);
            a0 += p * bf2f(v & 0xffffu); a1 += p * bf2f(v >> 16);
        }
        idx += s.count;
    }
    const float inv = 1.0f / l;
    o0 = a0 * inv; o1 = a1 * inv;
    LDS_WAIT();
}

__device__ __forceinline__ float slope_of(int i) { return exp2f(-0.5f * (float)(i + 1)); }

template <bool NB, bool NA, bool NC>
__device__ __forceinline__ void attn_naive_phase(const Args& a, int layer, const bf16_t* qkv, bf16_t* y, LAS unsigned char* lds) {
    const int tid_ = threadIdx.x;
    const int lane = tid_ & 63, wave = tid_ >> 6;
    const int gw = blockIdx.x * NWAVES + wave, NGW = gridDim.x * NWAVES;
    LAS float* sc = (LAS float*)(lds + wave * 17408);
    LAS float* qs = sc + 4096;
    const float lambda_init = 0.8f - 0.6f * expf(-0.3f * (float)layer);
    float lam;
    { const float* lq1 = a.in[8] + layer * 64; const float* lk1 = a.in[9] + layer * 64; const float* lq2 = a.in[10] + layer * 64; const float* lk2 = a.in[11] + layer * 64;
      const float s1 = wave_sum(lq1[lane] * lk1[lane]), s2 = wave_sum(lq2[lane] * lk2[lane]);
      lam = expf(s1) - expf(s2) + lambda_init; }
    const float* subln = a.in[12] + layer * HD;
    const float* sinkp = a.in[13] + layer * 6;
    const Seg none = {0, 0, 1};
    if (NB) for (int task = gw; task < T * 4; task += NGW) {
        const int tok = task >> 2, h = task & 3, b = tok / SEQ, t = tok % SEQ;
        const bf16_t* row = qkv + (size_t)tok * INW;
        const bf16_t* bb = qkv + (size_t)b * SEQ * INW;
        const float slope = slope_of(12 + h);
        const Seg all = {0, SEQ, 1};
        float p0, p1, q0, q1;
        attn_wave<64>(row + QB_ + h * 128, bb + KB_ + h * 128, bb + VB_ + h * 128, t, slope, 0.125f, all, none, none, 1, false, 0.f, qs, sc, lane, p0, p1);
        attn_wave<64>(row + QB_ + h * 128 + 64, bb + KB_ + h * 128 + 64, bb + VB_ + h * 128, t, slope, 0.125f, all, none, none, 1, false, 0.f, qs, sc, lane, q0, q1);
        const float o0 = p0 - lam * q0, o1 = p1 - lam * q1;
        const float ms = wave_sum(o0 * o0 + o1 * o1) * (1.0f / HD);
        const float r = rsqrtf(ms + RMS_EPS) * (1.0f - lambda_init);
        *(unsigned*)(y + (size_t)tok * DM + YB + h * 128 + 2 * lane) = pk2(o0 * r * subln[2 * lane], o1 * r * subln[2 * lane + 1]);
    }
    if (NA) for (int task = gw; task < T * 6; task += NGW) {
        const int tok = task / 6, h = task % 6, b = tok / SEQ, t = tok % SEQ;
        const bf16_t* row = qkv + (size_t)tok * INW;
        const bf16_t* bb = qkv + (size_t)b * SEQ * INW;
        Seg sg[3];
        const int dil[3] = {1, 4, 16};
#pragma unroll
        for (int i = 0; i < 3; ++i) { const int d = dil[i]; const int jlo = -min(64, t / d), jhi = min(64, (SEQ - 1 - t) / d);
            sg[i].start = t + jlo * d; sg[i].count = jhi - jlo + 1; sg[i].stride = d; }
        float o0, o1;
        attn_wave<128>(row + QA + h * 128, bb + KA + h * 128, bb + VA + h * 128, t, slope_of(6 + h), 0.08838834764831845f, sg[0], sg[1], sg[2], 3, false, 0.f, qs, sc, lane, o0, o1);
        *(unsigned*)(y + (size_t)tok * DM + YA + h * 128 + 2 * lane) = pk2(o0, o1);
    }
    if (NC) for (int task = gw; task < T * 6; task += NGW) {
        const int tok = task / 6, h = task % 6, b = tok / SEQ, t = tok % SEQ, kvh = h / 3;
        const bf16_t* row = qkv + (size_t)tok * INW;
        const bf16_t* bb = qkv + (size_t)b * SEQ * INW;
        const int jlo = -min(128, t), jhi = min(128, SEQ - 1 - t);
        const Seg s = {t + jlo, jhi - jlo + 1, 1};
        float o0, o1;
        attn_wave<128>(row + QC + h * 128, bb + KC + kvh * 128, bb + VC + kvh * 128, t, slope_of(h), 0.08838834764831845f, s, none, none, 1, true, sinkp[h], qs, sc, lane, o0, o1);
        *(unsigned*)(y + (size_t)tok * DM + YC + h * 128 + 2 * lane) = pk2(o0, o1);
    }
}

namespace att {
using s16x4 = __attribute__((ext_vector_type(4))) short;
constexpr int QBLK = 32, KVBLK = 64;
constexpr int SHM_V = KVBLK * 128 * 2, SHM_K = KVBLK * 128 * 2;
constexpr int SCR_OFF = 2 * SHM_V + 2 * SHM_K;
constexpr int XCH_OFF = 0;
#define KSWZ(row, colB) ((row) * 256 + ((colB) ^ (((row) & 7) << 4)))
#define SBAR() __builtin_amdgcn_sched_barrier(0)
__device__ __forceinline__ unsigned cvtpk(float lo, float hi) { unsigned r; asm volatile("v_cvt_pk_bf16_f32 %0, %1, %2" : "=v"(r) : "v"(lo), "v"(hi)); return r; }

template <int MODE> struct Cfg {
    static constexpr float SCALE = MODE == 1 ? 0.125f : 0.08838834764831845f;
    static constexpr int ND0 = MODE == 1 ? 4 : 8;
    static constexpr bool BAND = MODE != 1;
    static constexpr float RF = MODE == 0 ? 64.f : 128.f;
};
constexpr float THR = 8.f;

template <int MODE>
__device__ __forceinline__ void partialSM(f32x16& p0, f32x16& p1, float& m_reg, float& mn, float& alpha) {
    constexpr float SCALE = Cfg<MODE>::SCALE, C = SCALE * 1.4426950408889634f;
    float pmax = p0[0];
#pragma unroll
    for (int r = 1; r < 16; ++r) pmax = fmaxf(pmax, p0[r]);
#pragma unroll
    for (int r = 0; r < 16; ++r) pmax = fmaxf(pmax, p1[r]);
    { auto rr = __builtin_amdgcn_permlane32_swap(__float_as_uint(pmax), __float_as_uint(pmax), false, false);
      pmax = fmaxf(__uint_as_float(rr[0]), __uint_as_float(rr[1])); }
    if (__builtin_expect(__all(pmax - m_reg <= THR / SCALE), 1)) { mn = m_reg; alpha = 1.f; }
    else { mn = fmaxf(m_reg, pmax); alpha = __builtin_amdgcn_exp2f((m_reg - mn) * C); m_reg = mn; }
    const float mnC = -mn * C;
#pragma unroll
    for (int r = 0; r < 16; ++r) p0[r] = fmaf(p0[r], C, mnC);
#pragma unroll
    for (int r = 0; r < 16; ++r) p1[r] = fmaf(p1[r], C, mnC);
#pragma unroll
    for (int r = 0; r < 16; ++r) p0[r] = __builtin_amdgcn_exp2f(p0[r]);
}
__device__ __forceinline__ void finishSM(f32x16& p0, f32x16& p1, float alpha, float& l_reg, bf16x8& pa0, bf16x8& pa1, bf16x8& pa2, bf16x8& pa3) {
#pragma unroll
    for (int r = 0; r < 16; ++r) p1[r] = __builtin_amdgcn_exp2f(p1[r]);
    float ps = 0;
#pragma unroll
    for (int r = 0; r < 16; ++r) ps += p0[r];
#pragma unroll
    for (int r = 0; r < 16; ++r) ps += p1[r];
    { auto rr = __builtin_amdgcn_permlane32_swap(__float_as_uint(ps), __float_as_uint(ps), false, false);
      ps = __uint_as_float(rr[0]) + __uint_as_float(rr[1]); }
    l_reg = l_reg * alpha + ps;
#define PK4(P, BASE, OUT) do { unsigned a0 = cvtpk(P[BASE + 0], P[BASE + 1]), a1 = cvtpk(P[BASE + 2], P[BASE + 3]);   \
    unsigned b0 = cvtpk(P[BASE + 4], P[BASE + 5]), b1 = cvtpk(P[BASE + 6], P[BASE + 7]);                              \
    auto r0 = __builtin_amdgcn_permlane32_swap(a0, b0, false, false); auto r1 = __builtin_amdgcn_permlane32_swap(a1, b1, false, false); \
    u32x4 w = {r0[0], r1[0], r0[1], r1[1]}; OUT = *reinterpret_cast<bf16x8*>(&w); } while (0)
    PK4(p0, 0, pa0); PK4(p0, 8, pa1); PK4(p1, 0, pa2); PK4(p1, 8, pa3);
#undef PK4
}
template <int ND0>
__device__ __forceinline__ void qkt(f32x16& p0, f32x16& p1, const char* Ks, const bf16x8* qr, int r32, int hi, int colb0) {
    p0 = f32x16{}; p1 = f32x16{};
#pragma unroll
    for (int d0 = 0; d0 < ND0; ++d0) { const int cb = colb0 + (d0 * 16 + hi * 8) * 2;
        const bf16x8 b0 = *reinterpret_cast<const bf16x8*>(Ks + KSWZ(r32, cb));
        const bf16x8 b1 = *reinterpret_cast<const bf16x8*>(Ks + KSWZ(32 + r32, cb));
        p0 = __builtin_amdgcn_mfma_f32_32x32x16_bf16(b0, qr[d0], p0, 0, 0, 0);
        p1 = __builtin_amdgcn_mfma_f32_32x32x16_bf16(b1, qr[d0], p1, 0, 0, 0); }
}
template <bool BAND>
__device__ __forceinline__ void biasmask(f32x16& p0, f32x16& p1, float dq, float slopeS, float rf) {
#pragma unroll
    for (int r = 0; r < 16; ++r) { const float ad = __builtin_fabsf(dq + (float)((r & 3) + 8 * (r >> 2)));
        float v = fmaf(-slopeS, ad, p0[r]); if (BAND) v = ad > rf ? -INFINITY : v; p0[r] = v; }
#pragma unroll
    for (int r = 0; r < 16; ++r) { const float ad = __builtin_fabsf(dq + (float)(32 + (r & 3) + 8 * (r >> 2)));
        float v = fmaf(-slopeS, ad, p1[r]); if (BAND) v = ad > rf ? -INFINITY : v; p1[r] = v; }
}
__device__ __forceinline__ int v_st(int k, int c) { const int kk = (k & ~0xC) | ((k & 4) << 1) | ((k & 8) >> 1); return ((kk >> 3) * 4 + (c >> 5)) * 512 + ((kk & 7) * 32 + (c & 31)) * 2; }
__device__ __forceinline__ int v_rd_base(int lane) { return ((lane & 3) << 3) | (((lane >> 2) & 3) << 6) | (((lane >> 4) & 1) << 5) | (((lane >> 5) & 1) << 8); }
constexpr int v_rd_off(int d0, int ks, int half) { return d0 * 512 + ks * 4096 + half * 2048; }
template <int OFF> __device__ __forceinline__ s16x4 tr_read(int vb) {
    s16x4 r; asm volatile("ds_read_b64_tr_b16 %0, %1 offset:%2" : "=&v"(r) : "v"(vb), "i"(OFF) : "memory"); return r;
}
template <int D0> __device__ __forceinline__ void pv_one(f32x16& od, int vb, bf16x8 pa0, bf16x8 pa1, bf16x8 pa2, bf16x8 pa3) {
    const s16x4 l0 = tr_read<v_rd_off(D0, 0, 0)>(vb), h0 = tr_read<v_rd_off(D0, 0, 1)>(vb), l1 = tr_read<v_rd_off(D0, 1, 0)>(vb), h1 = tr_read<v_rd_off(D0, 1, 1)>(vb);
    const s16x4 l2 = tr_read<v_rd_off(D0, 2, 0)>(vb), h2 = tr_read<v_rd_off(D0, 2, 1)>(vb), l3 = tr_read<v_rd_off(D0, 3, 0)>(vb), h3 = tr_read<v_rd_off(D0, 3, 1)>(vb);
    asm volatile("s_waitcnt lgkmcnt(0)" ::: "memory"); SBAR();
#define PK(L, H) (bf16x8){L[0], L[1], L[2], L[3], H[0], H[1], H[2], H[3]}
    od = __builtin_amdgcn_mfma_f32_32x32x16_bf16(pa0, PK(l0, h0), od, 0, 0, 0);
    od = __builtin_amdgcn_mfma_f32_32x32x16_bf16(pa1, PK(l1, h1), od, 0, 0, 0);
    od = __builtin_amdgcn_mfma_f32_32x32x16_bf16(pa2, PK(l2, h2), od, 0, 0, 0);
    od = __builtin_amdgcn_mfma_f32_32x32x16_bf16(pa3, PK(l3, h3), od, 0, 0, 0);
#undef PK
}
__device__ __forceinline__ void pv_d0(f32x16* o, int vb, bf16x8 pa0, bf16x8 pa1, bf16x8 pa2, bf16x8 pa3) {
    pv_one<0>(o[0], vb, pa0, pa1, pa2, pa3); pv_one<1>(o[1], vb, pa0, pa1, pa2, pa3); pv_one<2>(o[2], vb, pa0, pa1, pa2, pa3); pv_one<3>(o[3], vb, pa0, pa1, pa2, pa3);
}

struct AU {
    const bf16_t* Q; const bf16_t* K; const bf16_t* V;
    long ld;
    int i0, tile_lo, nt;
    float slopeS;
    float* Of; long ldo; float* lse; long ldl;
    bf16_t* Ob;
    float sink, lam, post; const float* subln;
};

template <int MODE>
__device__ __forceinline__ void attn_unit(const AU& u, char* lds, int wv) {
    constexpr float SCALE = Cfg<MODE>::SCALE; constexpr int ND0 = Cfg<MODE>::ND0; constexpr bool BAND = Cfg<MODE>::BAND; constexpr float RF = Cfg<MODE>::RF;
    const int tid = wv * 64 + lane_now(), wid = wv,
              lane = tid & 63, r32 = lane & 31, hi = lane >> 5;
    const int rowoff = MODE == 1 ? (wid & 3) * 32 : wid * 32, cmap = MODE == 1 ? (wid >> 2) : 0;
    __syncthreads();
    char* V_lds = lds; char* K_lds = lds + 2 * SHM_V;
    float* wsf = (float*)(lds + SCR_OFF) + wid * 64; float* li_l = wsf; float* al_l = wsf + 32;
    float m_reg = -1e30f, l_reg = 0; f32x16 o[4] = {}; bf16x8 qr[ND0];
    const int qi = u.i0 + rowoff + r32;
    { const bf16_t* Qw = u.Q + (long)qi * u.ld + cmap * 64 + hi * 8;
#pragma unroll
      for (int d0 = 0; d0 < ND0; ++d0) qr[d0] = *reinterpret_cast<const bf16x8*>(Qw + d0 * 16); }
    const float dbase = (float)(4 * hi - qi), slopeS = u.slopeS;
    const int colb0 = cmap * 128;
    const int sr = tid >> 4, sc = (tid & 15) * 8, vst0 = v_st(sr, sc), vst1 = v_st(32 + sr, sc);
    const int vb0 = (int)(uintptr_t)V_lds + v_rd_base(lane);
    const bf16_t* Kh = u.K; const bf16_t* Vh = u.V; const long LDK = u.ld;
    struct { bf16x8 vs0, vs1, ks0, ks1; } sr_[2];
#define KT(j) ((u.tile_lo + (j)) * KVBLK)
#define SLOAD(i, k0) do { sr_[i].vs0 = *reinterpret_cast<const bf16x8*>(&Vh[(long)((k0) + sr) * LDK + sc]); sr_[i].vs1 = *reinterpret_cast<const bf16x8*>(&Vh[(long)((k0) + 32 + sr) * LDK + sc]); \
    sr_[i].ks0 = *reinterpret_cast<const bf16x8*>(&Kh[(long)((k0) + sr) * LDK + sc]); sr_[i].ks1 = *reinterpret_cast<const bf16x8*>(&Kh[(long)((k0) + 32 + sr) * LDK + sc]); } while (0)
#define SWRITE(b, i) do { *(bf16x8*)(V_lds + (b) * SHM_V + vst0) = sr_[i].vs0; *(bf16x8*)(V_lds + (b) * SHM_V + vst1) = sr_[i].vs1; const int kc = sc * 2; \
    *(bf16x8*)(K_lds + (b) * SHM_K + KSWZ(sr, kc)) = sr_[i].ks0; *(bf16x8*)(K_lds + (b) * SHM_K + KSWZ(32 + sr, kc)) = sr_[i].ks1; } while (0)
#define SWAIT() asm volatile("s_waitcnt vmcnt(4)" ::: "memory")
#define RESC(a) do { if (__any((a) < 1.f)) { if (hi == 0) al_l[r32] = (a); asm volatile("s_waitcnt lgkmcnt(0)" ::: "memory"); \
    _Pragma("unroll") for (int d = 0; d < 4; ++d) _Pragma("unroll") for (int r = 0; r < 16; ++r) o[d][r] *= al_l[crow(r, hi)]; } } while (0)
#define BIAS(P0, P1, j) biasmask<BAND>(P0, P1, dbase + (float)KT(j), slopeS, RF)
    f32x16 pA0, pA1, pB0, pB1; float mnA, mnB, alA, alB; bf16x8 pa0, pa1, pa2, pa3; const int NT = u.nt;
    constexpr int SE = 0, SO = 1;
    SLOAD(SE, KT(0)); asm volatile("s_waitcnt vmcnt(0)" ::: "memory"); SWRITE(0, SE); __syncthreads();
    qkt<ND0>(pA0, pA1, K_lds, qr, r32, hi, colb0); BIAS(pA0, pA1, 0); partialSM<MODE>(pA0, pA1, m_reg, mnA, alA);
    SLOAD(SO, KT(1)); if (2 < NT) SLOAD(SE, KT(2));
    SWAIT(); SWRITE(1, SO); __syncthreads();
    for (int j = 1; j + 1 < NT; j += 2) {
        SBAR(); qkt<ND0>(pB0, pB1, K_lds + SHM_K, qr, r32, hi, colb0);
        finishSM(pA0, pA1, alA, l_reg, pa0, pa1, pa2, pa3); SBAR();
        SLOAD(SO, KT(j + 2)); SBAR();
        pv_d0(o, vb0, pa0, pa1, pa2, pa3); BIAS(pB0, pB1, j); partialSM<MODE>(pB0, pB1, m_reg, mnB, alB);
        __syncthreads(); SWAIT(); SWRITE(0, SE);
        RESC(alB); __syncthreads();
        SBAR(); qkt<ND0>(pA0, pA1, K_lds, qr, r32, hi, colb0);
        finishSM(pB0, pB1, alB, l_reg, pa0, pa1, pa2, pa3); SBAR();
        if (j + 3 < NT) SLOAD(SE, KT(j + 3)); SBAR();
        pv_d0(o, vb0 + SHM_V, pa0, pa1, pa2, pa3); BIAS(pA0, pA1, j + 1); partialSM<MODE>(pA0, pA1, m_reg, mnA, alA);
        __syncthreads(); SWAIT(); SWRITE(1, SO);
        RESC(alA); __syncthreads();
    }
    SBAR(); qkt<ND0>(pB0, pB1, K_lds + SHM_K, qr, r32, hi, colb0);
    finishSM(pA0, pA1, alA, l_reg, pa0, pa1, pa2, pa3); SBAR();
    pv_d0(o, vb0, pa0, pa1, pa2, pa3); BIAS(pB0, pB1, NT - 1); partialSM<MODE>(pB0, pB1, m_reg, mnB, alB);
    __syncthreads(); RESC(alB);
    finishSM(pB0, pB1, alB, l_reg, pa0, pa1, pa2, pa3); SBAR();
    pv_d0(o, vb0 + SHM_V, pa0, pa1, pa2, pa3);
    if (MODE == 2) l_reg += __expf(u.sink - m_reg * SCALE);
    if (hi == 0) li_l[r32] = l_reg;
    asm volatile("s_waitcnt lgkmcnt(0)" ::: "memory");
    float rli[16];
#pragma unroll
    for (int r = 0; r < 16; ++r) rli[r] = __builtin_amdgcn_rcpf(li_l[crow(r, hi)]);
    if (MODE == 0) {
        if (hi == 0) u.lse[(long)qi * u.ldl] = m_reg * SCALE + __logf(l_reg);
        float* Ow = u.Of + (long)(u.i0 + rowoff) * u.ldo;
#pragma unroll
        for (int r = 0; r < 16; ++r) { const int orow = crow(r, hi);
#pragma unroll
            for (int d0 = 0; d0 < 4; ++d0) Ow[(long)orow * u.ldo + d0 * 32 + r32] = o[d0][r] * rli[r]; }
    } else if (MODE == 2) {
        bf16_t* Ow = u.Ob + (long)(u.i0 + rowoff) * DM;
#pragma unroll
        for (int r = 0; r < 16; ++r) { const int orow = crow(r, hi);
#pragma unroll
            for (int d0 = 0; d0 < 4; ++d0) Ow[(long)orow * DM + d0 * 32 + r32] = (bf16_t)f2bf(o[d0][r] * rli[r]); }
    } else {
        __syncthreads();
        float* X = (float*)(lds + XCH_OFF);
        if (cmap == 1) {
#pragma unroll
            for (int d0 = 0; d0 < 4; ++d0)
#pragma unroll
                for (int r = 0; r < 16; ++r) X[(((wid & 3) * 4 + d0) * 16 + r) * 64 + lane] = o[d0][r] * rli[r];
        }
        __syncthreads();
        if (cmap == 0) {
            const float lam = u.lam;
            float ssq[16];
#pragma unroll
            for (int r = 0; r < 16; ++r) ssq[r] = 0.f;
#pragma unroll
            for (int d0 = 0; d0 < 4; ++d0)
#pragma unroll
                for (int r = 0; r < 16; ++r) { const float v = o[d0][r] * rli[r] - lam * X[(((wid & 3) * 4 + d0) * 16 + r) * 64 + lane]; o[d0][r] = v; ssq[r] += v * v; }
#pragma unroll
            for (int r = 0; r < 16; ++r) { float s = ssq[r]; s = sum32(s);
                ssq[r] = rsqrtf(s * (1.0f / 128.0f) + RMS_EPS) * u.post; }
            bf16_t* Ow = u.Ob + (long)(u.i0 + rowoff) * DM;
#pragma unroll
            for (int d0 = 0; d0 < 4; ++d0) { const float gcol = u.subln[d0 * 32 + r32];
#pragma unroll
                for (int r = 0; r < 16; ++r) Ow[(long)crow(r, hi) * DM + d0 * 32 + r32] = (bf16_t)f2bf(o[d0][r] * ssq[r] * gcol); }
        }
    }
#undef KT
#undef SLOAD
#undef SWRITE
#undef SWAIT
#undef RESC
#undef BIAS
}
}

template <bool MB, bool MA, bool MC>
__device__ __forceinline__ void attn_mfma_phase(const Args& a, int layer, const bf16_t* qkv, bf16_t* y, float* part, float* lsebuf, char* lds, int wv) {
    const int lane = lane_now();
    const float lambda_init = 0.8f - 0.6f * expf(-0.3f * (float)layer);
    if (MB) {
        float lam;
        { const float* lq1 = a.in[8] + layer * 64; const float* lk1 = a.in[9] + layer * 64; const float* lq2 = a.in[10] + layer * 64; const float* lk2 = a.in[11] + layer * 64;
          const float s1 = wave_sum(lq1[lane] * lk1[lane]), s2 = wave_sum(lq2[lane] * lk2[lane]);
          lam = expf(s1) - expf(s2) + lambda_init; }
        for (int ub = blockIdx.x; ub < 256; ub += gridDim.x) {
            const int bh = ub & 7, qb = ub >> 3, b = bh >> 2, h = bh & 3;
            att::AU u{};
            const bf16_t* base = qkv + (size_t)b * SEQ * INW;
            u.Q = base + QB_ + h * 128; u.K = base + KB_ + h * 128; u.V = base + VB_ + h * 128; u.ld = INW;
            u.i0 = qb * 128; u.tile_lo = 0; u.nt = SEQ / 64; u.slopeS = slope_of(12 + h) * 8.0f;
            u.Ob = y + (size_t)b * SEQ * DM + YB + h * 128; u.lam = lam; u.post = 1.0f - lambda_init; u.subln = a.in[12] + layer * HD;
            att::attn_unit<1>(u, lds, wv);
        }
    }
    for (int us = blockIdx.x; us < 768; us += gridDim.x) {
        if (us < 576) {
            if (!MA) continue;
            const int branch = us / 192, r = us % 192, h = r % 6, rest = r / 6, b = rest >> 4, sub = rest & 15;
            const int dil = 1 << (2 * branch), L = SEQ / dil, nblk = L / 256, res = sub / nblk, blk = sub % nblk;
            const int ntl = L / 64, NT = ntl < 6 ? ntl : 6;
            int tl = blk * 4 - 1; tl = tl < 0 ? 0 : tl; tl = tl > ntl - NT ? ntl - NT : tl;
            att::AU u{};
            const size_t row0 = (size_t)b * SEQ + res;
            const bf16_t* base = qkv + row0 * INW;
            u.Q = base + QA + h * 128; u.K = base + KA + h * 128; u.V = base + VA + h * 128; u.ld = (long)dil * INW;
            u.i0 = blk * 256; u.tile_lo = tl; u.nt = NT; u.slopeS = slope_of(6 + h) * (float)dil * 11.313708498984761f;
            u.Of = part + (size_t)branch * T * 768 + row0 * 768 + h * 128; u.ldo = (long)dil * 768;
            u.lse = lsebuf + (size_t)branch * T * 6 + row0 * 6 + h; u.ldl = (long)dil * 6;
            att::attn_unit<0>(u, lds, wv);
        } else {
            if (!MC) continue;
            const int uc = us - 576, h = uc % 6, rest = uc / 6, b = rest >> 4, blk = rest & 15, kvh = h / 3;
            int tl = blk * 4 - 2; tl = tl < 0 ? 0 : tl; tl = tl > 56 ? 56 : tl;
            att::AU u{};
            const bf16_t* base = qkv + (size_t)b * SEQ * INW;
            u.Q = base + QC + h * 128; u.K = base + KC + kvh * 128; u.V = base + VC + kvh * 128; u.ld = INW;
            u.i0 = blk * 256; u.tile_lo = tl; u.nt = 8; u.slopeS = slope_of(h) * 11.313708498984761f;
            u.Ob = y + (size_t)b * SEQ * DM + YC + h * 128; u.sink = a.in[13][layer * 6 + h];
            att::attn_unit<2>(u, lds, wv);
        }
    }
}
__device__ __forceinline__ void combine_phase(const float* part, const float* lsebuf, bf16_t* y, int wv) {
    const int tid = opaque_tid(wv);
    for (int idx = blockIdx.x * NTHREADS + tid; idx < T * 96; idx += gridDim.x * NTHREADS) {
        const int tok = idx / 96, c8 = idx % 96, h = c8 >> 4, col = c8 * 8;
        const float l0 = lsebuf[(size_t)tok * 6 + h], l1 = lsebuf[(size_t)T * 6 + (size_t)tok * 6 + h], l2 = lsebuf[(size_t)2 * T * 6 + (size_t)tok * 6 + h];
        const float m = fmaxf(l0, fmaxf(l1, l2));
        float w0 = __expf(l0 - m), w1 = __expf(l1 - m), w2 = __expf(l2 - m); const float inv = 1.0f / (w0 + w1 + w2); w0 *= inv; w1 *= inv; w2 *= inv;
        const float* p0 = part + (size_t)tok * 768 + col; const float* p1 = p0 + (size_t)T * 768; const float* p2 = p1 + (size_t)T * 768;
        const f32x4 a0 = *(const f32x4*)p0, a1 = *(const f32x4*)(p0 + 4), b0 = *(const f32x4*)p1, b1 = *(const f32x4*)(p1 + 4), c0 = *(const f32x4*)p2, c1 = *(const f32x4*)(p2 + 4);
        const f32x4 v0 = a0 * w0 + b0 * w1 + c0 * w2, v1 = a1 * w0 + b1 * w1 + c1 * w2;
        u32x4 w; w.x = pk2(v0[0], v0[1]); w.y = pk2(v0[2], v0[3]); w.z = pk2(v1[0], v1[1]); w.w = pk2(v1[2], v1[3]);
        *(u32x4*)(y + (size_t)tok * DM + YA + col) = w;
    }
}

#define XB_TMO      128
#define XB_XCNT(j)  (256  + 64 * (j))
#define XB_XSUB(j)  (1280 + 64 * (j))
#define XB_XGEN(j)  (2304 + 64 * (j))
#define XB_TOP      3328
#define XB_TOPGEN   3392
#define XCD_BAR_WORDS 3456
#define XB_SPIN_CAP (1u << 18)

__device__ __forceinline__ unsigned xb_ld(unsigned* p)              { return __hip_atomic_load(p, __ATOMIC_RELAXED, __HIP_MEMORY_SCOPE_AGENT); }
__device__ __forceinline__ unsigned xb_add(unsigned* p, unsigned v) { return __hip_atomic_fetch_add(p, v, __ATOMIC_RELAXED, __HIP_MEMORY_SCOPE_AGENT); }
__device__ __forceinline__ unsigned xb_xcc_id() { return (unsigned)__builtin_amdgcn_s_getreg((3 << 11) | 20) & 0xFu; }
#define XB_SPIN(cond, bar) do { unsigned _sp = 0; while (cond) { __builtin_amdgcn_s_sleep(1); \
    if ((++_sp & 255u) == 0u) { if (xb_ld(&(bar)[XB_TMO])) break; if (_sp > XB_SPIN_CAP) { atomicAdd(&(bar)[XB_TMO], 1u); break; } } } } while (0)

struct XcdBarrier {
    int wv;
    unsigned* bar; unsigned x;
    volatile LAS unsigned* st;
};

__device__ __forceinline__ XcdBarrier xcd_barrier_post(unsigned* bar, volatile LAS unsigned* st, int wv) {
    XcdBarrier b; b.wv = wv; b.bar = bar; b.x = xb_xcc_id(); b.st = st;
    if (wv == 0 && lane_now() == 0) (void)xb_add(&bar[XB_XCNT(b.x)], 1u);
    return b;
}
__device__ __forceinline__ void xcd_barrier_complete(unsigned* bar, unsigned x, unsigned& nloc, unsigned& nx) {
    const unsigned G = gridDim.x * gridDim.y * gridDim.z;
    unsigned sum, cnt, mine, sp = 0u;
    for (;;) {
        sum = 0u; cnt = 0u; mine = 0u;
#pragma unroll
        for (unsigned j = 0; j < 16; ++j) { const unsigned c = xb_ld(&bar[XB_XCNT(j)]); sum += c; cnt += (c > 0u) ? 1u : 0u; mine = (j == x) ? c : mine; }
        if (sum == G) break;
        __builtin_amdgcn_s_sleep(1);
        if ((++sp & 255u) == 0u) { if (xb_ld(&bar[XB_TMO])) break; if (sp > XB_SPIN_CAP) { atomicAdd(&bar[XB_TMO], 1u); break; } }
    }
    nloc = mine > 0u ? mine : 1u; nx = cnt > 0u ? cnt : 1u;
}

__device__ __forceinline__ void xcd_barrier(const XcdBarrier& b) {
    asm volatile("s_waitcnt vmcnt(0)" ::: "memory");
    __syncthreads();
    if (b.wv == 0 && lane_now() == 0) {
        unsigned* bar = b.bar;
        __builtin_amdgcn_s_waitcnt(0);
        unsigned nloc = b.st[0], nx = b.st[1];
        if (nloc == 0u) { xcd_barrier_complete(bar, b.x, nloc, nx); b.st[0] = nloc; b.st[1] = nx; }
        const unsigned old = xb_add(&bar[XB_XSUB(b.x)], 1u);
        const unsigned gen = old / nloc;
        if (old + 1u == (gen + 1u) * nloc) {
            __builtin_amdgcn_fence(__ATOMIC_RELEASE, "agent");
            asm volatile("s_waitcnt vmcnt(0)" ::: "memory");
            const unsigned og = xb_add(&bar[XB_TOP], 1u);
            const unsigned tg = og / nx;
            if (og + 1u == (tg + 1u) * nx) xb_add(&bar[XB_TOPGEN], 1u);
            else XB_SPIN(xb_ld(&bar[XB_TOPGEN]) == tg, bar);
            __builtin_amdgcn_fence(__ATOMIC_ACQUIRE, "agent");
            xb_add(&bar[XB_XGEN(b.x)], 1u);
            asm volatile("s_waitcnt vmcnt(0)" ::: "memory");
        } else {
            XB_SPIN(xb_ld(&bar[XB_XGEN(b.x)]) == gen, bar);
            __builtin_amdgcn_fence(__ATOMIC_ACQUIRE, "agent");
            asm volatile("s_waitcnt vmcnt(0)" ::: "memory");
        }
    }
    __syncthreads();
}

constexpr int I_G = (DM / 64) * (DFF / 64), I_D = (DFF / 64) * (DM / 64), I_IN = (DM / 64) * (INW / 64), I_OUT = (DM / 64) * (DM / 64);
constexpr int PER_LAYER = 4 * I_G + 2 * I_D + I_IN + I_OUT, N_ITEMS = DEPTH * PER_LAYER;
constexpr int CV_P0 = 15872, CV_T1 = CV_P0 + 6400, CV_T2 = CV_T1 + 5120, CV_T3 = CV_T2 + 6400, CV_T4 = N_ITEMS;
static_assert(CV_P0 >= 2 * I_G + I_D && CV_T2 >= PER_LAYER && CV_T3 >= PER_LAYER + 2 * I_G + I_D + I_IN + I_OUT && CV_T3 <= N_ITEMS, "conversion slots cover every weight before its first use");
__device__ __forceinline__ TItem decode_item(const Args& a, unsigned char* ws, int it) {
    TItem t; const int l = it / PER_LAYER; int r = it % PER_LAYER;
    const size_t ogu = (size_t)l * DM * DFF;
    if (r < 2 * I_G + I_D) {
        t.g = a.in[1] + l * DM;
        if (r < I_G) { t.W = a.in[2] + ogu; t.K = DM; t.N = DFF; t.WT = (bf16_t*)(ws + WS_WGU + (size_t)(2 * l) * SZ_WGU); t.mode = 1; }
        else if (r < 2 * I_G) { r -= I_G; t.W = a.in[3] + ogu; t.K = DM; t.N = DFF; t.WT = (bf16_t*)(ws + WS_WGU + (size_t)(2 * l) * SZ_WGU); t.mode = 2; }
        else { r -= 2 * I_G; t.W = a.in[4] + ogu; t.K = DFF; t.N = DM; t.WT = (bf16_t*)(ws + WS_WD + (size_t)(2 * l) * SZ_WD); t.mode = 0; t.g = nullptr; }
    } else if (r < 2 * I_G + I_D + I_IN) { r -= 2 * I_G + I_D; t.W = a.in[6] + (size_t)l * DM * INW; t.K = DM; t.N = INW; t.g = a.in[5] + l * DM; t.WT = (bf16_t*)(ws + WS_WIN + (size_t)l * SZ_WIN); t.mode = 0; }
    else if (r < 2 * I_G + I_D + I_IN + I_OUT) { r -= 2 * I_G + I_D + I_IN; t.W = a.in[7] + (size_t)l * DM * DM; t.K = DM; t.N = DM; t.g = nullptr; t.WT = (bf16_t*)(ws + WS_WOUT + (size_t)l * SZ_WOUT); t.mode = 0; }
    else {
        r -= 2 * I_G + I_D + I_IN + I_OUT; t.g = a.in[14] + l * DM;
        if (r < I_G) { t.W = a.in[15] + ogu; t.K = DM; t.N = DFF; t.WT = (bf16_t*)(ws + WS_WGU + (size_t)(2 * l + 1) * SZ_WGU); t.mode = 1; }
        else if (r < 2 * I_G) { r -= I_G; t.W = a.in[16] + ogu; t.K = DM; t.N = DFF; t.WT = (bf16_t*)(ws + WS_WGU + (size_t)(2 * l + 1) * SZ_WGU); t.mode = 2; }
        else { r -= 2 * I_G; t.W = a.in[17] + ogu; t.K = DFF; t.N = DM; t.WT = (bf16_t*)(ws + WS_WD + (size_t)(2 * l + 1) * SZ_WD); t.mode = 0; t.g = nullptr; }
    }
    t.r = r; return t;
}
__device__ __forceinline__ void convert_range(const Args& a, unsigned char* ws, int begin, int end, int widx, int nworkers, LAS unsigned char* lds, int wv) {
    const int lane = lane_now();
    LAS unsigned char* scr = lds + wv * 9216;
    for (int it = begin + widx; it < end; it += 2 * nworkers) {
        const int it2 = it + nworkers; const bool two = it2 < end;
        const TItem t0 = decode_item(a, ws, it), t1 = decode_item(a, ws, two ? it2 : it);
        float v0[64], v1[64];
        titem_load(t0, lane, v0);
        if (two) titem_load(t1, lane, v1);
        titem_store(t0, lane, v0, scr);
        if (two) titem_store(t1, lane, v1, scr);
    }
}
__device__ __forceinline__ void tail_convert(const Args& a, unsigned char* ws, int nwg, int begin, int end, int wv, LAS unsigned char* lds) {
    const int G = gridDim.x, c = blockIdx.x, rounds = (nwg + G - 1) / G, nb = nwg - (rounds - 1) * G, wave = wv;
    if (nb >= G) convert_range(a, ws, begin, end, c * NWAVES + wave, G * NWAVES, lds, wv);
    else if (c >= nb) convert_range(a, ws, begin, end, (c - nb) * NWAVES + wave, (G - nb) * NWAVES, lds, wv);
}

__global__ void __launch_bounds__(NTHREADS, 2) fwd_kernel(Args a) {
    extern __shared__ __attribute__((aligned(16))) unsigned char lds_raw[];
    LAS unsigned char* lds = (LAS unsigned char*)lds_raw;
    cg::grid_group grid = cg::this_grid();
    const int tid = threadIdx.x, lane = tid & 63, wave = tid >> 6;
    const int wv = __builtin_amdgcn_readfirstlane(tid >> 6);
    const int gw = blockIdx.x * NWAVES + wave, NGW = gridDim.x * NWAVES;
    unsigned char* ws = a.ws;
    float* SS = (float*)(ws + WS_SS);
    bf16_t* XB = (bf16_t*)(ws + WS_XB);
    bf16_t* ACT = (bf16_t*)(ws + WS_ACT);
    bf16_t* QKV = (bf16_t*)(ws + WS_QKV);
    bf16_t* Y = (bf16_t*)(ws + WS_Y);
    float* PART = (float*)(ws + WS_PART); float* LSE = (float*)(ws + WS_LSE);
    float* XO = a.out;
    unsigned* BARW = (unsigned*)(ws + WS_BAR);
    volatile LAS unsigned* bar_st = (volatile LAS unsigned*)(lds + 131072 + 352);
    if (tid < 2) bar_st[tid] = 0u;
    __syncthreads();
    const XcdBarrier xbar = xcd_barrier_post(BARW, bar_st, wv);
    if (a.ws == nullptr) grid.sync();

    for (int rep = 0; rep <= PROBE_PRO; ++rep) {
        for (int i = blockIdx.x * NTHREADS + tid; i < 6 * T; i += gridDim.x * NTHREADS) SS[T + i] = 0.f;
        const float* x = a.in[0];
        for (int m = gw; m < T; m += NGW) {
            const f32x4* xr = (const f32x4*)(x + (size_t)m * DM) + lane; float s = 0.f;
            unsigned long long* o8 = (unsigned long long*)(XB + (size_t)m * DM) + lane;
#pragma unroll
            for (int j = 0; j < 8; ++j) { const f32x4 v = xr[64 * j]; s += (v.x * v.x + v.y * v.y) + (v.z * v.z + v.w * v.w);
                o8[64 * j] = (unsigned long long)pk2(v.x, v.y) | ((unsigned long long)pk2(v.z, v.w) << 32); }
            s = wave_sum(s);
            if (lane == 0) SS[m] = s;
        }
        convert_range(a, ws, 0, CV_P0, gw, NGW, lds, wv);
    }
    xcd_barrier(xbar);
    for (int rep = 0; rep < PROBE_SYNC; ++rep) xcd_barrier(xbar);

    for (int l = 0; l < DEPTH; ++l) {
        bf16_t* wgu1 = (bf16_t*)(ws + WS_WGU + (size_t)(2 * l + 0) * SZ_WGU); bf16_t* wgu2 = (bf16_t*)(ws + WS_WGU + (size_t)(2 * l + 1) * SZ_WGU);
        bf16_t* wd1 = (bf16_t*)(ws + WS_WD + (size_t)(2 * l + 0) * SZ_WD); bf16_t* wd2 = (bf16_t*)(ws + WS_WD + (size_t)(2 * l + 1) * SZ_WD);
        bf16_t* win = (bf16_t*)(ws + WS_WIN + (size_t)l * SZ_WIN); bf16_t* wout = (bf16_t*)(ws + WS_WOUT + (size_t)l * SZ_WOUT);
        float* ss0 = SS + (size_t)(3 * l + 0) * T; float* ss1 = SS + (size_t)(3 * l + 1) * T; float* ss2 = SS + (size_t)(3 * l + 2) * T; float* ss3 = SS + (size_t)(3 * l + 3) * T;
        const float* xin = (l == 0) ? a.in[0] : XO;
        for (int rep = 0; rep <= PROBE_GU; ++rep)
        { pg8::Gemm g{XB, wgu1, T, NGU, DM}; pg8::StaticOrder S; S.init(T, NGU, (int)gridDim.x, opaque_bid()); pg8::EpiGU E{ACT, ss0};
          pg8::gemm_phase<pg8::EpiGU, pg8::StaticOrder, true, true>(lds, g, S, E, wv); }
        if (l == 0) tail_convert(a, ws, (T / 256) * (NGU / 256), CV_P0, CV_T1, wv, lds); else tail_convert(a, ws, (T / 256) * (NGU / 256), CV_T3, CV_T4, wv, lds);
        xcd_barrier(xbar);
        { pg8::Gemm g{ACT, wd1, T, DM, DFF}; pg8::StaticOrder S; S.init(T, DM, (int)gridDim.x, opaque_bid()); pg8::EpiResid E{xin, XO, XB, ss1, 0.5f};
          pg8::gemm_phase<pg8::EpiResid, pg8::StaticOrder, true, true>(lds, g, S, E, wv); }
        xcd_barrier(xbar);
        { pg8::Gemm g{XB, win, T, INW, DM}; pg8::StaticOrder S; S.init(T, INW, (int)gridDim.x, opaque_bid()); pg8::EpiRow E{QKV, INW, ss1};
          pg8::gemm_phase<pg8::EpiRow, pg8::StaticOrder, true, true>(lds, g, S, E, wv); }
        if (l == 0) tail_convert(a, ws, (T / 256) * (INW / 256), CV_T1, CV_T2, wv, lds);
        xcd_barrier(xbar);
        for (int rep = 0; rep <= PROBE_ATTN; ++rep)
        attn_mfma_phase<MFMA_B, MFMA_A, MFMA_C>(a, l, QKV, Y, PART, LSE, (char*)lds_raw, wv);
        if (!(MFMA_B && MFMA_A && MFMA_C)) { __syncthreads(); attn_naive_phase<!MFMA_B, !MFMA_A, !MFMA_C>(a, l, QKV, Y, lds); }
        xcd_barrier(xbar);
        if (MFMA_A) { combine_phase(PART, LSE, Y, wv); xcd_barrier(xbar); }
        { pg8::Gemm g{Y, wout, T, DM, DM}; pg8::StaticOrder S; S.init(T, DM, (int)gridDim.x, opaque_bid()); pg8::EpiResid E{XO, XO, XB, ss2, 1.0f};
          pg8::gemm_phase<pg8::EpiResid, pg8::StaticOrder, true, true>(lds, g, S, E, wv); }
        xcd_barrier(xbar);
        { pg8::Gemm g{XB, wgu2, T, NGU, DM}; pg8::StaticOrder S; S.init(T, NGU, (int)gridDim.x, opaque_bid()); pg8::EpiGU E{ACT, ss2};
          pg8::gemm_phase<pg8::EpiGU, pg8::StaticOrder, true, true>(lds, g, S, E, wv); }
        if (l == 0) tail_convert(a, ws, (T / 256) * (NGU / 256), CV_T2, CV_T3, wv, lds);
        xcd_barrier(xbar);
        { pg8::Gemm g{ACT, wd2, T, DM, DFF}; pg8::StaticOrder S; S.init(T, DM, (int)gridDim.x, opaque_bid()); pg8::EpiResid E{XO, XO, XB, ss3, 0.5f};
          pg8::gemm_phase<pg8::EpiResid, pg8::StaticOrder, true, true>(lds, g, S, E, wv); }
        xcd_barrier(xbar);
    }
    {
        const float* ssf = SS + (size_t)6 * T; const float* g = a.in[18];
        const int lane = lane_now(), gw = blockIdx.x * NWAVES + wv;
        for (int m = gw; m < T; m += NGW) {
            const float rs = rstd_of(ssf, m);
            f32x4* xr = (f32x4*)(XO + (size_t)m * DM) + lane; const f32x4* gr = (const f32x4*)g + lane;
#pragma unroll
            for (int j = 0; j < 8; ++j) { f32x4 v = xr[64 * j]; const f32x4 gg = gr[64 * j]; v = v * rs * gg; xr[64 * j] = v; }
        }
    }
}

extern "C" void kernel_launch(void* const* d_in, const int* in_sizes, int n_in, void* d_out, int out_size, void* d_ws, size_t ws_size, hipStream_t stream) {
    static int grid = 0;
    if (grid == 0) {
        if (n_in != 19 || out_size != T * DM || ws_size < WS_END) { fprintf(stderr, "kernel_launch: unexpected shapes n_in %d out %d ws %zu (need %zu)\n", n_in, out_size, ws_size, (size_t)WS_END); grid = -1; return; }
        int dev = 0, cus = 0, per_cu = 0;
        hipGetDevice(&dev);
        hipDeviceGetAttribute(&cus, hipDeviceAttributeMultiprocessorCount, dev);
        if (hipFuncSetAttribute((const void*)fwd_kernel, hipFuncAttributeMaxDynamicSharedMemorySize, LDS_BYTES) != hipSuccess) { fprintf(stderr, "kernel_launch: hipFuncSetAttribute failed\n"); grid = -1; return; }
        if (hipOccupancyMaxActiveBlocksPerMultiprocessor(&per_cu, (const void*)fwd_kernel, NTHREADS, LDS_BYTES) != hipSuccess || per_cu < 1) { fprintf(stderr, "kernel_launch: occupancy query gave %d\n", per_cu); per_cu = 1; }
        (void)hipGetLastError();
        grid = cus * per_cu;
        fprintf(stderr, "kernel_launch: grid %d (cus %d x %d)\n", grid, cus, per_cu);
    }
    if (grid < 0) return;
    if (hipMemsetAsync((char*)d_ws + WS_BAR, 0, 16384, stream) != hipSuccess) { fprintf(stderr, "kernel_launch: hipMemsetAsync of the barrier words failed\n"); return; }
    Args a{};
    for (int i = 0; i < 19; ++i) a.in[i] = (const float*)d_in[i];
    a.out = (float*)d_out; a.ws = (unsigned char*)d_ws;
    void* args[] = {&a};
    hipError_t e = hipLaunchCooperativeKernel((const void*)fwd_kernel, dim3(grid), dim3(NTHREADS), args, LDS_BYTES, stream);
    if (e != hipSuccess) fprintf(stderr, "kernel_launch: cooperative launch failed: %s (grid %d)\n", hipGetErrorString(e), grid);
}
```

```cpp
#include <hip/hip_runtime.h>
#include <hip/hip_cooperative_groups.h>
#include <cstdio>
#include <cstdint>
namespace cg = cooperative_groups;

typedef unsigned short bf16_t;
typedef short bf16x8 __attribute__((ext_vector_type(8)));
typedef float f32x4 __attribute__((ext_vector_type(4)));
typedef float f32x16 __attribute__((ext_vector_type(16)));
typedef unsigned u32x4 __attribute__((ext_vector_type(4)));
#define LAS __attribute__((address_space(3)))

constexpr int BATCH = 2, SEQ = 4096, T = BATCH * SEQ, DM = 2048, DFF = 5504, NGU = 2 * DFF, INW = 5120, DEPTH = 2, HD = 128;
constexpr float RMS_EPS = 1e-6f;
constexpr int NWAVES = 8, NTHREADS = NWAVES * 64;
constexpr int LDS_BYTES = 147456;

constexpr int QA = 0, KA = 768, VA = 1536, QB_ = 2304, KB_ = 2816, VB_ = 3328, QC = 3840, KC = 4608, VC = 4864;
constexpr int YA = 0, YB = 768, YC = 1280;

constexpr size_t al256(size_t x) { return (x + 255) / 256 * 256; }
constexpr size_t WS_SS = 0;
constexpr size_t SZ_SS = (size_t)7 * T * 4;
constexpr size_t SZ_WGU = (size_t)NGU * DM * 2, SZ_WD = (size_t)DM * DFF * 2, SZ_WIN = (size_t)INW * DM * 2, SZ_WOUT = (size_t)DM * DM * 2;
constexpr size_t WS_BAR = al256(WS_SS + SZ_SS);
constexpr size_t WS_WGU = WS_BAR + 16384;
constexpr size_t WS_WD = WS_WGU + 4 * SZ_WGU;
constexpr size_t WS_WIN = WS_WD + 4 * SZ_WD;
constexpr size_t WS_WOUT = WS_WIN + 2 * SZ_WIN;
constexpr size_t WS_XB = WS_WOUT + 2 * SZ_WOUT;
constexpr size_t WS_ACT = WS_XB + (size_t)T * DM * 2;
constexpr size_t WS_QKV = WS_ACT;
constexpr size_t WS_Y = WS_ACT + (size_t)T * DFF * 2;
constexpr size_t WS_PART = WS_Y + (size_t)T * DM * 2;
constexpr size_t WS_LSE = WS_PART + (size_t)3 * T * 768 * 4;
constexpr size_t WS_END = WS_LSE + (size_t)3 * T * 6 * 4;
#ifndef PROBE_PRO
#define PROBE_PRO 0
#endif
#ifndef PROBE_SYNC
#define PROBE_SYNC 0
#endif
#ifndef PROBE_ATTN
#define PROBE_ATTN 0
#endif
#ifndef PROBE_GU
#define PROBE_GU 0
#endif
#ifndef MFMA_B
#define MFMA_B true
#endif
#ifndef MFMA_A
#define MFMA_A true
#endif
#ifndef MFMA_C
#define MFMA_C true
#endif

struct Args { const float* in[19]; float* out; unsigned char* ws; };

__device__ __forceinline__ unsigned f2bf(float f) { unsigned u = __float_as_uint(f); return (u + 0x7fffu + ((u >> 16) & 1u)) >> 16; }
__device__ __forceinline__ unsigned pk2(float lo, float hi) { return f2bf(lo) | (f2bf(hi) << 16); }
__device__ __forceinline__ float bf2f(unsigned b) { return __uint_as_float(b << 16); }
__device__ __forceinline__ int crow(int r, int hi) { return (r & 3) + 8 * (r >> 2) + 4 * hi; }
template <int M> __device__ __forceinline__ float xswz(float v) { return __uint_as_float((unsigned)__builtin_amdgcn_ds_swizzle((int)__float_as_uint(v), (M << 10) | 0x1f)); }
__device__ __forceinline__ float half_sum(float v) { auto rr = __builtin_amdgcn_permlane32_swap(__float_as_uint(v), __float_as_uint(v), false, false); return __uint_as_float(rr[0]) + __uint_as_float(rr[1]); }
__device__ __forceinline__ float half_max(float v) { auto rr = __builtin_amdgcn_permlane32_swap(__float_as_uint(v), __float_as_uint(v), false, false); return fmaxf(__uint_as_float(rr[0]), __uint_as_float(rr[1])); }
__device__ __forceinline__ float sum32(float v) { v += xswz<1>(v); v += xswz<2>(v); v += xswz<4>(v); v += xswz<8>(v); v += xswz<16>(v); return v; }
__device__ __forceinline__ float wave_sum(float v) { return half_sum(sum32(v)); }
__device__ __forceinline__ float wave_max(float v) { v = fmaxf(v, xswz<1>(v)); v = fmaxf(v, xswz<2>(v)); v = fmaxf(v, xswz<4>(v)); v = fmaxf(v, xswz<8>(v)); v = fmaxf(v, xswz<16>(v)); return half_max(v); }
__device__ __forceinline__ int lane_now() { int l; asm volatile("v_mbcnt_lo_u32_b32 %0, -1, 0\n\tv_mbcnt_hi_u32_b32 %0, -1, %0" : "=v"(l)); return l; }
#define LDS_WAIT() asm volatile("s_waitcnt lgkmcnt(0)" ::: "memory")
__device__ __forceinline__ int opaque_bid() { int b = blockIdx.x; asm volatile("" : "+s"(b)); return b; }
__device__ __forceinline__ int opaque_tid(int wv) { return wv * 64 + lane_now(); }

struct TItem { const float* W; const float* g; bf16_t* WT; int K, N, mode, r; };
__device__ __forceinline__ void titem_load(const TItem& t, int lane, float (&v)[64]) {
    const int nblk = t.N / 64, kb = t.r / nblk, nb = t.r % nblk, k0 = 64 * kb, n0 = 64 * nb;
    const float* src = t.W + (size_t)k0 * t.N + n0 + lane;
#pragma unroll
    for (int i = 0; i < 64; ++i) v[i] = __builtin_nontemporal_load(src + (size_t)i * t.N);
}
__device__ __forceinline__ void titem_store(const TItem& t, int lane, float (&v)[64], LAS unsigned char* scr) {
    const int nblk = t.N / 64, kb = t.r / nblk, nb = t.r % nblk, k0 = 64 * kb, n0 = 64 * nb;
    if (t.g) {
#pragma unroll
        for (int i = 0; i < 64; ++i) v[i] *= t.g[k0 + i];
    }
    LAS u32x4* wrow = (LAS u32x4*)(scr + lane * 144);
#pragma unroll
    for (int j = 0; j < 8; ++j) { u32x4 o; o.x = pk2(v[8 * j], v[8 * j + 1]); o.y = pk2(v[8 * j + 2], v[8 * j + 3]); o.z = pk2(v[8 * j + 4], v[8 * j + 5]); o.w = pk2(v[8 * j + 6], v[8 * j + 7]);
        wrow[j] = o; }
    LDS_WAIT();
    const int drow0 = (t.mode == 0 ? n0 : (n0 / 128) * 256 + (n0 % 128) + (t.mode == 2 ? 128 : 0));
    const int c = lane & 7, nn = lane >> 3;
#pragma unroll
    for (int j = 0; j < 8; ++j) { const int n = nn + 8 * j;
        const u32x4 o = *(const LAS u32x4*)(scr + n * 144 + c * 16);
        *(u32x4*)(t.WT + (size_t)(drow0 + n) * t.K + k0 + 8 * c) = o; }
    LDS_WAIT();
}

namespace pg8 {
#define PG8_LAS __attribute__((address_space(3)))
typedef unsigned short bf16_t;
typedef short bf16x8 __attribute__((ext_vector_type(8)));
typedef float f32x4 __attribute__((ext_vector_type(4)));
typedef unsigned u32x4 __attribute__((ext_vector_type(4)));
constexpr int BM = 256, BK = 64, HALF = 128, HTB = HALF * BK * 2  , STAGE_BYTES = 8 * HTB, NXCD = 8, WGM = 8;

__host__ __device__ __forceinline__ int lds_byte(int r, int c) { const int st = (r >> 4) * 2 + (c >> 5), rr = r & 15, cc = c & 31, ob = rr * 64 + cc * 2; return st * 1024 + (ob ^ (((ob >> 9) & 1) << 5)); }
__host__ __device__ __forceinline__ void stage_rc(int b, int& R, int& C) { const int st = b / 1024, sb = b % 1024, swz = sb ^ (((sb >> 9) & 1) << 5); R = (st >> 1) * 16 + swz / 64; C = (st & 1) * 32 + (swz % 64) / 2; }
__host__ __device__ __forceinline__ int perm32(int rho) { const int n = rho >> 4, i = rho & 15; return 8 * (i >> 2) + 4 * n + (i & 3); }

struct Unit { int pm, pn; };
struct Gemm { const bf16_t* A; const bf16_t* Bt; int M, N, K; };

struct StaticOrder {
    int nM, nN, nwg, G, c;
    __host__ __device__ void init(int M, int N, int G_, int c_) { nM = M / BM; nN = N / BM; nwg = nM * nN; G = G_; c = c_; }
    __host__ __device__ bool next(int i, Unit& u) const {
        const long L = (long)i * G + c; if (L >= nwg) return false;
        int wgid = (int)L; { const int q = nwg / NXCD, r = nwg % NXCD, xcd = wgid % NXCD, off = wgid / NXCD; wgid = (xcd < r ? xcd * (q + 1) : r * (q + 1) + (xcd - r) * q) + off; }
        const int nig = WGM * nN, gid = wgid / nig, fm = gid * WGM, gsz = (nM - fm) < WGM ? (nM - fm) : WGM;
        u.pm = fm + ((wgid % nig) % gsz); u.pn = (wgid % nig) / gsz; return true;
    }
    __device__ __forceinline__ void a_ready(const Unit&) const {}
    __device__ __forceinline__ void done(const Unit&) const {}
};

__device__ __forceinline__ unsigned cvt_pk_bf16(float lo, float hi) { unsigned r; asm volatile("v_cvt_pk_bf16_f32 %0, %1, %2" : "=v"(r) : "v"(lo), "v"(hi)); return r; }
__device__ __forceinline__ float rstd2048(const float* ss, int row) { return rsqrtf(ss[row] * (1.0f / 2048.0f) + 1e-6f); }
struct EpiGU {
    static constexpr bool PERM = true, AFTER_DRAIN = false;
    bf16_t* O; const float* ss;
    __device__ __forceinline__ void operator()(const f32x4 (&acc)[2][2][4][2], const Unit& u, int wr, int wc, int fr, int fq) const {
        const int row0 = u.pm * BM + wr * 64 + fr, col0 = u.pn * HALF + wc * 32 + 8 * fq;
#pragma unroll
        for (int ai = 0; ai < 2; ++ai)
#pragma unroll
            for (int m = 0; m < 4; ++m) {
                const int row = row0 + ai * HALF + m * 16; const float rs = rstd2048(ss, row);
                float o[8];
#pragma unroll
                for (int n = 0; n < 2; ++n)
#pragma unroll
                    for (int e = 0; e < 4; ++e) { const float g = acc[ai][0][m][n][e] * rs, uu = acc[ai][1][m][n][e] * rs;
                        o[4 * n + e] = g * __builtin_amdgcn_rcpf(1.0f + __expf(-g)) * uu; }
                u32x4 w; w.x = cvt_pk_bf16(o[0], o[1]); w.y = cvt_pk_bf16(o[2], o[3]); w.z = cvt_pk_bf16(o[4], o[5]); w.w = cvt_pk_bf16(o[6], o[7]);
                *(u32x4*)(O + (size_t)row * 5504 + col0) = w;
            }
    }
};
struct EpiRow {
    static constexpr bool PERM = true, AFTER_DRAIN = false;
    bf16_t* O; int ldc; const float* ss;
    __device__ __forceinline__ void operator()(const f32x4 (&acc)[2][2][4][2], const Unit& u, int wr, int wc, int fr, int fq) const {
        const int row0 = u.pm * BM + wr * 64 + fr, col0 = u.pn * BM + wc * 32 + 8 * fq;
#pragma unroll
        for (int ai = 0; ai < 2; ++ai)
#pragma unroll
            for (int m = 0; m < 4; ++m) {
                const int row = row0 + ai * HALF + m * 16; const float rs = rstd2048(ss, row);
#pragma unroll
                for (int bj = 0; bj < 2; ++bj) { const f32x4 v0 = acc[ai][bj][m][0] * rs, v1 = acc[ai][bj][m][1] * rs;
                    u32x4 w; w.x = cvt_pk_bf16(v0[0], v0[1]); w.y = cvt_pk_bf16(v0[2], v0[3]); w.z = cvt_pk_bf16(v1[0], v1[1]); w.w = cvt_pk_bf16(v1[2], v1[3]);
                    *(u32x4*)(O + (size_t)row * ldc + col0 + bj * HALF) = w; }
            }
    }
};
struct EpiResid {
    static constexpr bool PERM = true, AFTER_DRAIN = false;
    const float* xi; float* xo; bf16_t* xb; float* ssn; float alpha;
    __device__ __forceinline__ void operator()(const f32x4 (&acc)[2][2][4][2], const Unit& u, int wr, int wc, int fr, int fq) const {
        const int row0 = u.pm * BM + wr * 64 + fr, col0 = u.pn * BM + wc * 32 + 8 * fq;
#pragma unroll
        for (int ai = 0; ai < 2; ++ai)
#pragma unroll
            for (int m = 0; m < 4; ++m) {
                const int row = row0 + ai * HALF + m * 16; float s = 0.f;
#pragma unroll
                for (int bj = 0; bj < 2; ++bj) { const size_t off = (size_t)row * 2048 + col0 + bj * HALF;
                    const f32x4 v0 = *(const f32x4*)(xi + off) + acc[ai][bj][m][0] * alpha, v1 = *(const f32x4*)(xi + off + 4) + acc[ai][bj][m][1] * alpha;
                    *(f32x4*)(xo + off) = v0; *(f32x4*)(xo + off + 4) = v1;
                    u32x4 w; w.x = cvt_pk_bf16(v0[0], v0[1]); w.y = cvt_pk_bf16(v0[2], v0[3]); w.z = cvt_pk_bf16(v1[0], v1[1]); w.w = cvt_pk_bf16(v1[2], v1[3]);
                    *(u32x4*)(xb + off) = w;
                    s += (v0[0] * v0[0] + v0[1] * v0[1]) + (v0[2] * v0[2] + v0[3] * v0[3]) + (v1[0] * v1[0] + v1[1] * v1[1]) + (v1[2] * v1[2] + v1[3] * v1[3]); }
                s += xswz<16>(s); s = half_sum(s);
                if (fq == 0) atomicAdd(ssn + row, s);
            }
    }
};
template <class Epi, class Sched, bool ALIGN_EPI = false, bool SP2 = false>
__device__ __forceinline__ void gemm_phase(PG8_LAS unsigned char* lds, const Gemm g, const Sched& S, const Epi& E, int wv) {
    const int tid_ = wv * 64 + lane_now();
    const int tid = tid_, wid = __builtin_amdgcn_readfirstlane(tid >> 6), lane = tid & 63, wr = wid >> 2, wc = wid & 3, fr = lane & 15, fq = lane >> 4;
    const int K = g.K, nt = K / BK;
    unsigned voffA[2], voffB[2];
#pragma unroll
    for (int i = 0; i < 2; ++i) { int R, C; stage_rc(tid * 16 + i * 8192, R, C); const int Rb = Epi::PERM ? ((R & ~31) + perm32(R & 31)) : R;
        voffA[i] = (unsigned)(R * K + C) * 2u; voffB[i] = (unsigned)(Rb * K + C) * 2u; }
    const size_t kstep = (size_t)(BK * 2);
    const size_t hstep = (size_t)HALF * K * 2;
    const size_t tstep = 2 * hstep;
    const unsigned ldsw = (unsigned)wid * 1024u;
    const int aoff = lds_byte(wr * 64 + fr, fq * 8), boff = lds_byte(wc * 32 + fr, fq * 8);
#define PG8_SA(b, h) (((b) * 2 + (h)) * HTB)
#define PG8_SB(b, h) ((4 + (b) * 2 + (h)) * HTB)
#define PG8_STAGE(bufoff, gbase, voff) do { _Pragma("unroll") for (int _i = 0; _i < 2; ++_i) \
        __builtin_amdgcn_global_load_lds((const unsigned*)((const char*)(gbase) + (voff)[_i]), (PG8_LAS unsigned*)(lds + (bufoff) + ldsw + _i * 8192), 16, 0, 0); } while (0)
#define PG8_LDA(dst, b, h) do { _Pragma("unroll") for (int m = 0; m < 4; ++m) _Pragma("unroll") for (int k = 0; k < 2; ++k) dst[m][k] = *(const PG8_LAS bf16x8*)(lds + PG8_SA(b, h) + aoff + m * 2048 + k * 1024); } while (0)
#define PG8_LDB(dst, b, h) do { _Pragma("unroll") for (int n = 0; n < 2; ++n) _Pragma("unroll") for (int k = 0; k < 2; ++k) dst[n][k] = *(const PG8_LAS bf16x8*)(lds + PG8_SB(b, h) + boff + n * 2048 + k * 1024); } while (0)
#define PG8_MMA(ai, bj, At, Bt) do { __builtin_amdgcn_s_setprio(1); _Pragma("unroll") for (int m = 0; m < 4; ++m) _Pragma("unroll") for (int n = 0; n < 2; ++n) _Pragma("unroll") for (int k = 0; k < 2; ++k) \
        acc[ai][bj][m][n] = __builtin_amdgcn_mfma_f32_16x16x32_bf16(Bt[n][k], At[m][k], acc[ai][bj][m][n], 0, 0, 0); __builtin_amdgcn_s_setprio(0); } while (0)
#define PG8_WAIT_V(n) asm volatile("s_waitcnt vmcnt(" #n ")" ::: "memory")
#define PG8_WAIT_L(n) asm volatile("s_waitcnt lgkmcnt(" #n ")" ::: "memory")
#define PG8_BAR __builtin_amdgcn_s_barrier()
#define PG8_SCHED __builtin_amdgcn_sched_barrier(0)
    Unit cur, nxt; int ui = 0;
    if (!S.next(0, cur)) return;
    f32x4 acc[2][2][4][2];
#pragma unroll
    for (int a = 0; a < 2; ++a)
#pragma unroll
        for (int b = 0; b < 2; ++b)
#pragma unroll
            for (int m = 0; m < 4; ++m)
#pragma unroll
                for (int n = 0; n < 2; ++n) acc[a][b][m][n] = (f32x4){0.f, 0.f, 0.f, 0.f};
    bf16x8 At[4][2], B0[2][2], B1[2][2];
    const char* cA = (const char*)g.A + (size_t)cur.pm * tstep; const char* cB = (const char*)g.Bt + (size_t)cur.pn * tstep;
    S.a_ready(cur);
    if constexpr (SP2) {
        PG8_STAGE(PG8_SB(0, 0), cB, voffB); PG8_STAGE(PG8_SB(0, 1), cB + hstep, voffB); PG8_STAGE(PG8_SA(0, 0), cA, voffA); PG8_STAGE(PG8_SA(0, 1), cA + hstep, voffA);
        if (wr == 1) PG8_BAR;
        PG8_WAIT_V(2); PG8_BAR;
        PG8_STAGE(PG8_SB(1, 0), cB + kstep, voffB); PG8_STAGE(PG8_SA(1, 0), cA + kstep, voffA); PG8_STAGE(PG8_SB(1, 1), cB + hstep + kstep, voffB);
        PG8_WAIT_V(6); PG8_BAR;
    } else {
        PG8_STAGE(PG8_SB(0, 0), cB, voffB); PG8_STAGE(PG8_SA(0, 0), cA, voffA); PG8_STAGE(PG8_SB(0, 1), cB + hstep, voffB); PG8_STAGE(PG8_SA(0, 1), cA + hstep, voffA);
        if (wr == 1) PG8_BAR;
        PG8_WAIT_V(4); PG8_BAR;
        PG8_STAGE(PG8_SB(1, 0), cB + kstep, voffB); PG8_STAGE(PG8_SA(1, 0), cA + kstep, voffA); PG8_STAGE(PG8_SB(1, 1), cB + hstep + kstep, voffB);
        PG8_WAIT_V(6); PG8_BAR;
    }
    for (;;) {
        const bool has_next = S.next(ui + 1, nxt);
        const char* nA = has_next ? (const char*)g.A + (size_t)nxt.pm * tstep : cA; const char* nB = has_next ? (const char*)g.Bt + (size_t)nxt.pn * tstep : cB;
        for (int t = 0; t < nt; t += 2) {
            const bool last = (t == nt - 2);
            const char* a1 = cA + (size_t)(t + 1) * kstep;
            const char* a2 = last ? nA : cA + (size_t)(t + 2) * kstep; const char* b2 = last ? nB : cB + (size_t)(t + 2) * kstep;
            const char* a3 = a2 + kstep; const char* b3 = b2 + kstep;
            if (last && has_next) S.a_ready(nxt);
            if constexpr (SP2) {
            PG8_LDB(B0, 0, 0); PG8_LDB(B1, 0, 1); PG8_SCHED; PG8_LDA(At, 0, 0); PG8_STAGE(PG8_SA(1, 1), a1 + hstep, voffA);
            PG8_WAIT_V(8); PG8_WAIT_L(0); PG8_BAR; PG8_MMA(0, 0, At, B0); PG8_MMA(0, 1, At, B1); PG8_BAR; PG8_SCHED;
            PG8_LDA(At, 0, 1); PG8_STAGE(PG8_SB(0, 0), b2, voffB); PG8_STAGE(PG8_SB(0, 1), b2 + hstep, voffB); PG8_STAGE(PG8_SA(0, 0), a2, voffA);
            PG8_WAIT_V(8); PG8_WAIT_L(0); PG8_BAR; PG8_MMA(1, 0, At, B0); PG8_MMA(1, 1, At, B1); PG8_BAR; PG8_SCHED;
            PG8_LDB(B0, 1, 0); PG8_LDB(B1, 1, 1); PG8_SCHED; PG8_LDA(At, 1, 0); PG8_STAGE(PG8_SA(0, 1), a2 + hstep, voffA);
            PG8_WAIT_V(8); PG8_WAIT_L(0); PG8_BAR; PG8_MMA(0, 0, At, B0); PG8_MMA(0, 1, At, B1); PG8_BAR; PG8_SCHED;
            PG8_LDA(At, 1, 1); PG8_STAGE(PG8_SB(1, 0), b3, voffB); PG8_STAGE(PG8_SB(1, 1), b3 + hstep, voffB); PG8_STAGE(PG8_SA(1, 0), a3, voffA);
            PG8_WAIT_V(8); PG8_WAIT_L(0); PG8_BAR; PG8_MMA(1, 0, At, B0); PG8_MMA(1, 1, At, B1); PG8_BAR; PG8_SCHED;
            } else {
            PG8_LDB(B0, 0, 0); PG8_SCHED; PG8_LDA(At, 0, 0); PG8_STAGE(PG8_SA(1, 1), a1 + hstep, voffA);
            PG8_WAIT_L(8); PG8_BAR; PG8_WAIT_L(0); PG8_MMA(0, 0, At, B0); PG8_BAR; PG8_SCHED;
            PG8_LDB(B1, 0, 1); PG8_STAGE(PG8_SB(0, 0), b2, voffB);
            PG8_BAR; PG8_WAIT_L(0); PG8_MMA(0, 1, At, B1); PG8_BAR;
            PG8_LDA(At, 0, 1); PG8_STAGE(PG8_SA(0, 0), a2, voffA);
            PG8_BAR; PG8_WAIT_L(0); PG8_MMA(1, 0, At, B0); PG8_BAR; PG8_SCHED;
            PG8_STAGE(PG8_SB(0, 1), b2 + hstep, voffB);
            PG8_WAIT_V(6); PG8_BAR; PG8_MMA(1, 1, At, B1); PG8_BAR;
            PG8_LDB(B0, 1, 0); PG8_SCHED; PG8_LDA(At, 1, 0); PG8_STAGE(PG8_SA(0, 1), a2 + hstep, voffA);
            PG8_WAIT_L(8); PG8_BAR; PG8_WAIT_L(0); PG8_MMA(0, 0, At, B0); PG8_BAR; PG8_SCHED;
            PG8_LDB(B1, 1, 1); PG8_STAGE(PG8_SB(1, 0), b3, voffB);
            PG8_BAR; PG8_WAIT_L(0); PG8_MMA(0, 1, At, B1); PG8_BAR;
            PG8_LDA(At, 1, 1); PG8_STAGE(PG8_SA(1, 0), a3, voffA);
            PG8_BAR; PG8_WAIT_L(0); PG8_MMA(1, 0, At, B0); PG8_BAR; PG8_SCHED;
            PG8_STAGE(PG8_SB(1, 1), b3 + hstep, voffB);
            PG8_WAIT_V(6); PG8_BAR; PG8_MMA(1, 1, At, B1); PG8_BAR;
            }
        }
        if constexpr (ALIGN_EPI) { if (wr == 0) PG8_BAR; }
        if constexpr (!Epi::AFTER_DRAIN) { E(acc, cur, wr, wc, fr, fq); S.done(cur); }
        if (!has_next) break;
#pragma unroll
        for (int a = 0; a < 2; ++a)
#pragma unroll
            for (int b = 0; b < 2; ++b)
#pragma unroll
                for (int m = 0; m < 4; ++m)
#pragma unroll
                    for (int n = 0; n < 2; ++n) acc[a][b][m][n] = (f32x4){0.f, 0.f, 0.f, 0.f};
        cur = nxt; cA = nA; cB = nB; ++ui;
        if constexpr (ALIGN_EPI) { if (wr == 1) PG8_BAR; }
    }
    PG8_WAIT_V(0);
    if constexpr (!ALIGN_EPI) { if (wr == 0) PG8_BAR; }
    PG8_BAR;
    if constexpr (Epi::AFTER_DRAIN) { E.fused(acc, cur, wr, wc, fr, fq, lds, wid, lane); S.done(cur); }
#undef PG8_SA
#undef PG8_SB
#undef PG8_STAGE
#undef PG8_LDA
#undef PG8_LDB
#undef PG8_MMA
#undef PG8_WAIT_V
#undef PG8_WAIT_L
#undef PG8_BAR
#undef PG8_SCHED
}
}

__device__ __forceinline__ float rstd_of(const float* ss, int row) { return rsqrtf(ss[row] * (1.0f / DM) + RMS_EPS); }

struct Seg { int start, count, stride; };

template <int DQ>
__device__ __forceinline__ void attn_wave(const bf16_t* qrow, const bf16_t* kb, const bf16_t* vb, int t, float slope, float scale,
                                          Seg s0, Seg s1, Seg s2, int nseg, bool has_sink, float sink,
                                          LAS float* qs, LAS float* sc, int lane, float& o0, float& o1) {
    for (int d = lane; d < DQ; d += 64) qs[d] = bf2f(qrow[d]);
    LDS_WAIT();
    float m = -1e30f; int base = 0;
    for (int si = 0; si < nseg; ++si) {
        const Seg s = si == 0 ? s0 : (si == 1 ? s1 : s2);
        for (int i = lane; i < s.count; i += 64) {
            const int pos = s.start + i * s.stride;
            const bf16_t* kr = kb + (size_t)pos * INW;
            float dot = 0.f;
            for (int d = 0; d < DQ; d += 8) {
                const bf16x8 kv = *(const bf16x8*)(kr + d);
#pragma unroll
                for (int e = 0; e < 8; ++e) dot += qs[d + e] * bf2f((unsigned short)kv[e]);
            }
            const int dist = t > pos ? t - pos : pos - t;
            const float val = dot * scale - slope * (float)dist;
            sc[base + i] = val; m = fmaxf(m, val);
        }
        base += s.count;
    }
    m = wave_max(m);
    if (has_sink) m = fmaxf(m, sink);
    float l = 0.f;
    for (int i = lane; i < base; i += 64) { const float p = __expf(sc[i] - m); sc[i] = p; l += p; }
    l = wave_sum(l);
    if (has_sink) l += __expf(sink - m);
    LDS_WAIT();
    float a0 = 0.f, a1 = 0.f; int idx = 0;
    for (int si = 0; si < nseg; ++si) {
        const Seg s = si == 0 ? s0 : (si == 1 ? s1 : s2);
        for (int i = 0; i < s.count; ++i) {
            const int pos = s.start + i * s.stride;
            const float p = sc[idx + i];
            const unsigned v = *(const unsigned*)(vb + (size_t)pos * INW + 2 * lane);
            a0 += p * bf2f(v & 0xffffu); a1 += p * bf2f(v >> 16);
        }
        idx += s.count;
    }
    const float inv = 1.0f / l;
    o0 = a0 * inv; o1 = a1 * inv;
    LDS_WAIT();
}

__device__ __forceinline__ float slope_of(int i) { return exp2f(-0.5f * (float)(i + 1)); }

template <bool NB, bool NA, bool NC>
__device__ __forceinline__ void attn_naive_phase(const Args& a, int layer, const bf16_t* qkv, bf16_t* y, LAS unsigned char* lds) {
    const int tid_ = threadIdx.x;
    const int lane = tid_ & 63, wave = tid_ >> 6;
    const int gw = blockIdx.x * NWAVES + wave, NGW = gridDim.x * NWAVES;
    LAS float* sc = (LAS float*)(lds + wave * 17408);
    LAS float* qs = sc + 4096;
    const float lambda_init = 0.8f - 0.6f * expf(-0.3f * (float)layer);
    float lam;
    { const float* lq1 = a.in[8] + layer * 64; const float* lk1 = a.in[9] + layer * 64; const float* lq2 = a.in[10] + layer * 64; const float* lk2 = a.in[11] + layer * 64;
      const float s1 = wave_sum(lq1[lane] * lk1[lane]), s2 = wave_sum(lq2[lane] * lk2[lane]);
      lam = expf(s1) - expf(s2) + lambda_init; }
    const float* subln = a.in[12] + layer * HD;
    const float* sinkp = a.in[13] + layer * 6;
    const Seg none = {0, 0, 1};
    if (NB) for (int task = gw; task < T * 4; task += NGW) {
        const int tok = task >> 2, h = task & 3, b = tok / SEQ, t = tok % SEQ;
        const bf16_t* row = qkv + (size_t)tok * INW;
        const bf16_t* bb = qkv + (size_t)b * SEQ * INW;
        const float slope = slope_of(12 + h);
        const Seg all = {0, SEQ, 1};
        float p0, p1, q0, q1;
        attn_wave<64>(row + QB_ + h * 128, bb + KB_ + h * 128, bb + VB_ + h * 128, t, slope, 0.125f, all, none, none, 1, false, 0.f, qs, sc, lane, p0, p1);
        attn_wave<64>(row + QB_ + h * 128 + 64, bb + KB_ + h * 128 + 64, bb + VB_ + h * 128, t, slope, 0.125f, all, none, none, 1, false, 0.f, qs, sc, lane, q0, q1);
        const float o0 = p0 - lam * q0, o1 = p1 - lam * q1;
        const float ms = wave_sum(o0 * o0 + o1 * o1) * (1.0f / HD);
        const float r = rsqrtf(ms + RMS_EPS) * (1.0f - lambda_init);
        *(unsigned*)(y + (size_t)tok * DM + YB + h * 128 + 2 * lane) = pk2(o0 * r * subln[2 * lane], o1 * r * subln[2 * lane + 1]);
    }
    if (NA) for (int task = gw; task < T * 6; task += NGW) {
        const int tok = task / 6, h = task % 6, b = tok / SEQ, t = tok % SEQ;
        const bf16_t* row = qkv + (size_t)tok * INW;
        const bf16_t* bb = qkv + (size_t)b * SEQ * INW;
        Seg sg[3];
        const int dil[3] = {1, 4, 16};
#pragma unroll
        for (int i = 0; i < 3; ++i) { const int d = dil[i]; const int jlo = -min(64, t / d), jhi = min(64, (SEQ - 1 - t) / d);
            sg[i].start = t + jlo * d; sg[i].count = jhi - jlo + 1; sg[i].stride = d; }
        float o0, o1;
        attn_wave<128>(row + QA + h * 128, bb + KA + h * 128, bb + VA + h * 128, t, slope_of(6 + h), 0.08838834764831845f, sg[0], sg[1], sg[2], 3, false, 0.f, qs, sc, lane, o0, o1);
        *(unsigned*)(y + (size_t)tok * DM + YA + h * 128 + 2 * lane) = pk2(o0, o1);
    }
    if (NC) for (int task = gw; task < T * 6; task += NGW) {
        const int tok = task / 6, h = task % 6, b = tok / SEQ, t = tok % SEQ, kvh = h / 3;
        const bf16_t* row = qkv + (size_t)tok * INW;
        const bf16_t* bb = qkv + (size_t)b * SEQ * INW;
        const int jlo = -min(128, t), jhi = min(128, SEQ - 1 - t);
        const Seg s = {t + jlo, jhi - jlo + 1, 1};
        float o0, o1;
        attn_wave<128>(row + QC + h * 128, bb + KC + kvh * 128, bb + VC + kvh * 128, t, slope_of(h), 0.08838834764831845f, s, none, none, 1, true, sinkp[h], qs, sc, lane, o0, o1);
        *(unsigned*)(y + (size_t)tok * DM + YC + h * 128 + 2 * lane) = pk2(o0, o1);
    }
}

namespace att {
using s16x4 = __attribute__((ext_vector_type(4))) short;
constexpr int QBLK = 32, KVBLK = 64;
constexpr int SHM_V = KVBLK * 128 * 2, SHM_K = KVBLK * 128 * 2;
constexpr int SCR_OFF = 2 * SHM_V + 2 * SHM_K;
constexpr int XCH_OFF = 0;
#define KSWZ(row, colB) ((row) * 256 + ((colB) ^ (((row) & 7) << 4)))
#define SBAR() __builtin_amdgcn_sched_barrier(0)
__device__ __forceinline__ unsigned cvtpk(float lo, float hi) { unsigned r; asm volatile("v_cvt_pk_bf16_f32 %0, %1, %2" : "=v"(r) : "v"(lo), "v"(hi)); return r; }

template <int MODE> struct Cfg {
    static constexpr float SCALE = MODE == 1 ? 0.125f : 0.08838834764831845f;
    static constexpr int ND0 = MODE == 1 ? 4 : 8;
    static constexpr bool BAND = MODE != 1;
    static constexpr float RF = MODE == 0 ? 64.f : 128.f;
};
constexpr float THR = 8.f;

template <int MODE>
__device__ __forceinline__ void partialSM(f32x16& p0, f32x16& p1, float& m_reg, float& mn, float& alpha) {
    constexpr float SCALE = Cfg<MODE>::SCALE, C = SCALE * 1.4426950408889634f;
    float pmax = p0[0];
#pragma unroll
    for (int r = 1; r < 16; ++r) pmax = fmaxf(pmax, p0[r]);
#pragma unroll
    for (int r = 0; r < 16; ++r) pmax = fmaxf(pmax, p1[r]);
    { auto rr = __builtin_amdgcn_permlane32_swap(__float_as_uint(pmax), __float_as_uint(pmax), false, false);
      pmax = fmaxf(__uint_as_float(rr[0]), __uint_as_float(rr[1])); }
    if (__builtin_expect(__all(pmax - m_reg <= THR / SCALE), 1)) { mn = m_reg; alpha = 1.f; }
    else { mn = fmaxf(m_reg, pmax); alpha = __builtin_amdgcn_exp2f((m_reg - mn) * C); m_reg = mn; }
    const float mnC = -mn * C;
#pragma unroll
    for (int r = 0; r < 16; ++r) p0[r] = fmaf(p0[r], C, mnC);
#pragma unroll
    for (int r = 0; r < 16; ++r) p1[r] = fmaf(p1[r], C, mnC);
#pragma unroll
    for (int r = 0; r < 16; ++r) p0[r] = __builtin_amdgcn_exp2f(p0[r]);
}
__device__ __forceinline__ void finishSM(f32x16& p0, f32x16& p1, float alpha, float& l_reg, bf16x8& pa0, bf16x8& pa1, bf16x8& pa2, bf16x8& pa3) {
#pragma unroll
    for (int r = 0; r < 16; ++r) p1[r] = __builtin_amdgcn_exp2f(p1[r]);
    float ps = 0;
#pragma unroll
    for (int r = 0; r < 16; ++r) ps += p0[r];
#pragma unroll
    for (int r = 0; r < 16; ++r) ps += p1[r];
    { auto rr = __builtin_amdgcn_permlane32_swap(__float_as_uint(ps), __float_as_uint(ps), false, false);
      ps = __uint_as_float(rr[0]) + __uint_as_float(rr[1]); }
    l_reg = l_reg * alpha + ps;
#define PK4(P, BASE, OUT) do { unsigned a0 = cvtpk(P[BASE + 0], P[BASE + 1]), a1 = cvtpk(P[BASE + 2], P[BASE + 3]);   \
    unsigned b0 = cvtpk(P[BASE + 4], P[BASE + 5]), b1 = cvtpk(P[BASE + 6], P[BASE + 7]);                              \
    auto r0 = __builtin_amdgcn_permlane32_swap(a0, b0, false, false); auto r1 = __builtin_amdgcn_permlane32_swap(a1, b1, false, false); \
    u32x4 w = {r0[0], r1[0], r0[1], r1[1]}; OUT = *reinterpret_cast<bf16x8*>(&w); } while (0)
    PK4(p0, 0, pa0); PK4(p0, 8, pa1); PK4(p1, 0, pa2); PK4(p1, 8, pa3);
#undef PK4
}
template <int ND0>
__device__ __forceinline__ void qkt(f32x16& p0, f32x16& p1, const char* Ks, const bf16x8* qr, int r32, int hi, int colb0) {
    p0 = f32x16{}; p1 = f32x16{};
#pragma unroll
    for (int d0 = 0; d0 < ND0; ++d0) { const int cb = colb0 + (d0 * 16 + hi * 8) * 2;
        const bf16x8 b0 = *reinterpret_cast<const bf16x8*>(Ks + KSWZ(r32, cb));
        const bf16x8 b1 = *reinterpret_cast<const bf16x8*>(Ks + KSWZ(32 + r32, cb));
        p0 = __builtin_amdgcn_mfma_f32_32x32x16_bf16(b0, qr[d0], p0, 0, 0, 0);
        p1 = __builtin_amdgcn_mfma_f32_32x32x16_bf16(b1, qr[d0], p1, 0, 0, 0); }
}
template <bool BAND>
__device__ __forceinline__ void biasmask(f32x16& p0, f32x16& p1, float dq, float slopeS, float rf) {
#pragma unroll
    for (int r = 0; r < 16; ++r) { const float ad = __builtin_fabsf(dq + (float)((r & 3) + 8 * (r >> 2)));
        float v = fmaf(-slopeS, ad, p0[r]); if (BAND) v = ad > rf ? -INFINITY : v; p0[r] = v; }
#pragma unroll
    for (int r = 0; r < 16; ++r) { const float ad = __builtin_fabsf(dq + (float)(32 + (r & 3) + 8 * (r >> 2)));
        float v = fmaf(-slopeS, ad, p1[r]); if (BAND) v = ad > rf ? -INFINITY : v; p1[r] = v; }
}
__device__ __forceinline__ int v_st(int k, int c) { const int kk = (k & ~0xC) | ((k & 4) << 1) | ((k & 8) >> 1); return ((kk >> 3) * 4 + (c >> 5)) * 512 + ((kk & 7) * 32 + (c & 31)) * 2; }
__device__ __forceinline__ int v_rd_base(int lane) { return ((lane & 3) << 3) | (((lane >> 2) & 3) << 6) | (((lane >> 4) & 1) << 5) | (((lane >> 5) & 1) << 8); }
constexpr int v_rd_off(int d0, int ks, int half) { return d0 * 512 + ks * 4096 + half * 2048; }
template <int OFF> __device__ __forceinline__ s16x4 tr_read(int vb) {
    s16x4 r; asm volatile("ds_read_b64_tr_b16 %0, %1 offset:%2" : "=&v"(r) : "v"(vb), "i"(OFF) : "memory"); return r;
}
template <int D0> __device__ __forceinline__ void pv_one(f32x16& od, int vb, bf16x8 pa0, bf16x8 pa1, bf16x8 pa2, bf16x8 pa3) {
    const s16x4 l0 = tr_read<v_rd_off(D0, 0, 0)>(vb), h0 = tr_read<v_rd_off(D0, 0, 1)>(vb), l1 = tr_read<v_rd_off(D0, 1, 0)>(vb), h1 = tr_read<v_rd_off(D0, 1, 1)>(vb);
    const s16x4 l2 = tr_read<v_rd_off(D0, 2, 0)>(vb), h2 = tr_read<v_rd_off(D0, 2, 1)>(vb), l3 = tr_read<v_rd_off(D0, 3, 0)>(vb), h3 = tr_read<v_rd_off(D0, 3, 1)>(vb);
    asm volatile("s_waitcnt lgkmcnt(0)" ::: "memory"); SBAR();
#define PK(L, H) (bf16x8){L[0], L[1], L[2], L[3], H[0], H[1], H[2], H[3]}
    od = __builtin_amdgcn_mfma_f32_32x32x16_bf16(pa0, PK(l0, h0), od, 0, 0, 0);
    od = __builtin_amdgcn_mfma_f32_32x32x16_bf16(pa1, PK(l1, h1), od, 0, 0, 0);
    od = __builtin_amdgcn_mfma_f32_32x32x16_bf16(pa2, PK(l2, h2), od, 0, 0, 0);
    od = __builtin_amdgcn_mfma_f32_32x32x16_bf16(pa3, PK(l3, h3), od, 0, 0, 0);
#undef PK
}
__device__ __forceinline__ void pv_d0(f32x16* o, int vb, bf16x8 pa0, bf16x8 pa1, bf16x8 pa2, bf16x8 pa3) {
    pv_one<0>(o[0], vb, pa0, pa1, pa2, pa3); pv_one<1>(o[1], vb, pa0, pa1, pa2, pa3); pv_one<2>(o[2], vb, pa0, pa1, pa2, pa3); pv_one<3>(o[3], vb, pa0, pa1, pa2, pa3);
}

struct AU {
    const bf16_t* Q; const bf16_t* K; const bf16_t* V;
    long ld;
    int i0, tile_lo, nt;
    float slopeS;
    float* Of; long ldo; float* lse; long ldl;
    bf16_t* Ob;
    float sink, lam, post; const float* subln;
};

template <int MODE>
__device__ __forceinline__ void attn_unit(const AU& u, char* lds, int wv) {
    constexpr float SCALE = Cfg<MODE>::SCALE; constexpr int ND0 = Cfg<MODE>::ND0; constexpr bool BAND = Cfg<MODE>::BAND; constexpr float RF = Cfg<MODE>::RF;
    const int tid = wv * 64 + lane_now(), wid = wv,
              lane = tid & 63, r32 = lane & 31, hi = lane >> 5;
    const int rowoff = MODE == 1 ? (wid & 3) * 32 : wid * 32, cmap = MODE == 1 ? (wid >> 2) : 0;
    __syncthreads();
    char* V_lds = lds; char* K_lds = lds + 2 * SHM_V;
    float* wsf = (float*)(lds + SCR_OFF) + wid * 64; float* li_l = wsf; float* al_l = wsf + 32;
    float m_reg = -1e30f, l_reg = 0; f32x16 o[4] = {}; bf16x8 qr[ND0];
    const int qi = u.i0 + rowoff + r32;
    { const bf16_t* Qw = u.Q + (long)qi * u.ld + cmap * 64 + hi * 8;
#pragma unroll
      for (int d0 = 0; d0 < ND0; ++d0) qr[d0] = *reinterpret_cast<const bf16x8*>(Qw + d0 * 16); }
    const float dbase = (float)(4 * hi - qi), slopeS = u.slopeS;
    const int colb0 = cmap * 128;
    const int sr = tid >> 4, sc = (tid & 15) * 8, vst0 = v_st(sr, sc), vst1 = v_st(32 + sr, sc);
    const int vb0 = (int)(uintptr_t)V_lds + v_rd_base(lane);
    const bf16_t* Kh = u.K; const bf16_t* Vh = u.V; const long LDK = u.ld;
    struct { bf16x8 vs0, vs1, ks0, ks1; } sr_[2];
#define KT(j) ((u.tile_lo + (j)) * KVBLK)
#define SLOAD(i, k0) do { sr_[i].vs0 = *reinterpret_cast<const bf16x8*>(&Vh[(long)((k0) + sr) * LDK + sc]); sr_[i].vs1 = *reinterpret_cast<const bf16x8*>(&Vh[(long)((k0) + 32 + sr) * LDK + sc]); \
    sr_[i].ks0 = *reinterpret_cast<const bf16x8*>(&Kh[(long)((k0) + sr) * LDK + sc]); sr_[i].ks1 = *reinterpret_cast<const bf16x8*>(&Kh[(long)((k0) + 32 + sr) * LDK + sc]); } while (0)
#define SWRITE(b, i) do { *(bf16x8*)(V_lds + (b) * SHM_V + vst0) = sr_[i].vs0; *(bf16x8*)(V_lds + (b) * SHM_V + vst1) = sr_[i].vs1; const int kc = sc * 2; \
    *(bf16x8*)(K_lds + (b) * SHM_K + KSWZ(sr, kc)) = sr_[i].ks0; *(bf16x8*)(K_lds + (b) * SHM_K + KSWZ(32 + sr, kc)) = sr_[i].ks1; } while (0)
#define SWAIT() asm volatile("s_waitcnt vmcnt(4)" ::: "memory")
#define RESC(a) do { if (__any((a) < 1.f)) { if (hi == 0) al_l[r32] = (a); asm volatile("s_waitcnt lgkmcnt(0)" ::: "memory"); \
    _Pragma("unroll") for (int d = 0; d < 4; ++d) _Pragma("unroll") for (int r = 0; r < 16; ++r) o[d][r] *= al_l[crow(r, hi)]; } } while (0)
#define BIAS(P0, P1, j) biasmask<BAND>(P0, P1, dbase + (float)KT(j), slopeS, RF)
    f32x16 pA0, pA1, pB0, pB1; float mnA, mnB, alA, alB; bf16x8 pa0, pa1, pa2, pa3; const int NT = u.nt;
    constexpr int SE = 0, SO = 1;
    SLOAD(SE, KT(0)); asm volatile("s_waitcnt vmcnt(0)" ::: "memory"); SWRITE(0, SE); __syncthreads();
    qkt<ND0>(pA0, pA1, K_lds, qr, r32, hi, colb0); BIAS(pA0, pA1, 0); partialSM<MODE>(pA0, pA1, m_reg, mnA, alA);
    SLOAD(SO, KT(1)); if (2 < NT) SLOAD(SE, KT(2));
    SWAIT(); SWRITE(1, SO); __syncthreads();
    for (int j = 1; j + 1 < NT; j += 2) {
        SBAR(); qkt<ND0>(pB0, pB1, K_lds + SHM_K, qr, r32, hi, colb0);
        finishSM(pA0, pA1, alA, l_reg, pa0, pa1, pa2, pa3); SBAR();
        SLOAD(SO, KT(j + 2)); SBAR();
        pv_d0(o, vb0, pa0, pa1, pa2, pa3); BIAS(pB0, pB1, j); partialSM<MODE>(pB0, pB1, m_reg, mnB, alB);
        __syncthreads(); SWAIT(); SWRITE(0, SE);
        RESC(alB); __syncthreads();
        SBAR(); qkt<ND0>(pA0, pA1, K_lds, qr, r32, hi, colb0);
        finishSM(pB0, pB1, alB, l_reg, pa0, pa1, pa2, pa3); SBAR();
        if (j + 3 < NT) SLOAD(SE, KT(j + 3)); SBAR();
        pv_d0(o, vb0 + SHM_V, pa0, pa1, pa2, pa3); BIAS(pA0, pA1, j + 1); partialSM<MODE>(pA0, pA1, m_reg, mnA, alA);
        __syncthreads(); SWAIT(); SWRITE(1, SO);
        RESC(alA); __syncthreads();
    }
    SBAR(); qkt<ND0>(pB0, pB1, K_lds + SHM_K, qr, r32, hi, colb0);
    finishSM(pA0, pA1, alA, l_reg, pa0, pa1, pa2, pa3); SBAR();
    pv_d0(o, vb0, pa0, pa1, pa2, pa3); BIAS(pB0, pB1, NT - 1); partialSM<MODE>(pB0, pB1, m_reg, mnB, alB);
    __syncthreads(); RESC(alB);
    finishSM(pB0, pB1, alB, l_reg, pa0, pa1, pa2, pa3); SBAR();
    pv_d0(o, vb0 + SHM_V, pa0, pa1, pa2, pa3);
    if (MODE == 2) l_reg += __expf(u.sink - m_reg * SCALE);
    if (hi == 0) li_l[r32] = l_reg;
    asm volatile("s_waitcnt lgkmcnt(0)" ::: "memory");
    float rli[16];
#pragma unroll
    for (int r = 0; r < 16; ++r) rli[r] = __builtin_amdgcn_rcpf(li_l[crow(r, hi)]);
    if (MODE == 0) {
        if (hi == 0) u.lse[(long)qi * u.ldl] = m_reg * SCALE + __logf(l_reg);
        float* Ow = u.Of + (long)(u.i0 + rowoff) * u.ldo;
#pragma unroll
        for (int r = 0; r < 16; ++r) { const int orow = crow(r, hi);
#pragma unroll
            for (int d0 = 0; d0 < 4; ++d0) Ow[(long)orow * u.ldo + d0 * 32 + r32] = o[d0][r] * rli[r]; }
    } else if (MODE == 2) {
        bf16_t* Ow = u.Ob + (long)(u.i0 + rowoff) * DM;
#pragma unroll
        for (int r = 0; r < 16; ++r) { const int orow = crow(r, hi);
#pragma unroll
            for (int d0 = 0; d0 < 4; ++d0) Ow[(long)orow * DM + d0 * 32 + r32] = (bf16_t)f2bf(o[d0][r] * rli[r]); }
    } else {
        __syncthreads();
        float* X = (float*)(lds + XCH_OFF);
        if (cmap == 1) {
#pragma unroll
            for (int d0 = 0; d0 < 4; ++d0)
#pragma unroll
                for (int r = 0; r < 16; ++r) X[(((wid & 3) * 4 + d0) * 16 + r) * 64 + lane] = o[d0][r] * rli[r];
        }
        __syncthreads();
        if (cmap == 0) {
            const float lam = u.lam;
            float ssq[16];
#pragma unroll
            for (int r = 0; r < 16; ++r) ssq[r] = 0.f;
#pragma unroll
            for (int d0 = 0; d0 < 4; ++d0)
#pragma unroll
                for (int r = 0; r < 16; ++r) { const float v = o[d0][r] * rli[r] - lam * X[(((wid & 3) * 4 + d0) * 16 + r) * 64 + lane]; o[d0][r] = v; ssq[r] += v * v; }
#pragma unroll
            for (int r = 0; r < 16; ++r) { float s = ssq[r]; s = sum32(s);
                ssq[r] = rsqrtf(s * (1.0f / 128.0f) + RMS_EPS) * u.post; }
            bf16_t* Ow = u.Ob + (long)(u.i0 + rowoff) * DM;
#pragma unroll
            for (int d0 = 0; d0 < 4; ++d0) { const float gcol = u.subln[d0 * 32 + r32];
#pragma unroll
                for (int r = 0; r < 16; ++r) Ow[(long)crow(r, hi) * DM + d0 * 32 + r32] = (bf16_t)f2bf(o[d0][r] * ssq[r] * gcol); }
        }
    }
#undef KT
#undef SLOAD
#undef SWRITE
#undef SWAIT
#undef RESC
#undef BIAS
}
}

template <bool MB, bool MA, bool MC>
__device__ __forceinline__ void attn_mfma_phase(const Args& a, int layer, const bf16_t* qkv, bf16_t* y, float* part, float* lsebuf, char* lds, int wv) {
    const int lane = lane_now();
    const float lambda_init = 0.8f - 0.6f * expf(-0.3f * (float)layer);
    if (MB) {
        float lam;
        { const float* lq1 = a.in[8] + layer * 64; const float* lk1 = a.in[9] + layer * 64; const float* lq2 = a.in[10] + layer * 64; const float* lk2 = a.in[11] + layer * 64;
          const float s1 = wave_sum(lq1[lane] * lk1[lane]), s2 = wave_sum(lq2[lane] * lk2[lane]);
          lam = expf(s1) - expf(s2) + lambda_init; }
        for (int ub = blockIdx.x; ub < 256; ub += gridDim.x) {
            const int bh = ub & 7, qb = ub >> 3, b = bh >> 2, h = bh & 3;
            att::AU u{};
            const bf16_t* base = qkv + (size_t)b * SEQ * INW;
            u.Q = base + QB_ + h * 128; u.K = base + KB_ + h * 128; u.V = base + VB_ + h * 128; u.ld = INW;
            u.i0 = qb * 128; u.tile_lo = 0; u.nt = SEQ / 64; u.slopeS = slope_of(12 + h) * 8.0f;
            u.Ob = y + (size_t)b * SEQ * DM + YB + h * 128; u.lam = lam; u.post = 1.0f - lambda_init; u.subln = a.in[12] + layer * HD;
            att::attn_unit<1>(u, lds, wv);
        }
    }
    for (int us = blockIdx.x; us < 768; us += gridDim.x) {
        if (us < 576) {
            if (!MA) continue;
            const int branch = us / 192, r = us % 192, h = r % 6, rest = r / 6, b = rest >> 4, sub = rest & 15;
            const int dil = 1 << (2 * branch), L = SEQ / dil, nblk = L / 256, res = sub / nblk, blk = sub % nblk;
            const int ntl = L / 64, NT = ntl < 6 ? ntl : 6;
            int tl = blk * 4 - 1; tl = tl < 0 ? 0 : tl; tl = tl > ntl - NT ? ntl - NT : tl;
            att::AU u{};
            const size_t row0 = (size_t)b * SEQ + res;
            const bf16_t* base = qkv + row0 * INW;
            u.Q = base + QA + h * 128; u.K = base + KA + h * 128; u.V = base + VA + h * 128; u.ld = (long)dil * INW;
            u.i0 = blk * 256; u.tile_lo = tl; u.nt = NT; u.slopeS = slope_of(6 + h) * (float)dil * 11.313708498984761f;
            u.Of = part + (size_t)branch * T * 768 + row0 * 768 + h * 128; u.ldo = (long)dil * 768;
            u.lse = lsebuf + (size_t)branch * T * 6 + row0 * 6 + h; u.ldl = (long)dil * 6;
            att::attn_unit<0>(u, lds, wv);
        } else {
            if (!MC) continue;
            const int uc = us - 576, h = uc % 6, rest = uc / 6, b = rest >> 4, blk = rest & 15, kvh = h / 3;
            int tl = blk * 4 - 2; tl = tl < 0 ? 0 : tl; tl = tl > 56 ? 56 : tl;
            att::AU u{};
            const bf16_t* base = qkv + (size_t)b * SEQ * INW;
            u.Q = base + QC + h * 128; u.K = base + KC + kvh * 128; u.V = base + VC + kvh * 128; u.ld = INW;
            u.i0 = blk * 256; u.tile_lo = tl; u.nt = 8; u.slopeS = slope_of(h) * 11.313708498984761f;
            u.Ob = y + (size_t)b * SEQ * DM + YC + h * 128; u.sink = a.in[13][layer * 6 + h];
            att::attn_unit<2>(u, lds, wv);
        }
    }
}
__device__ __forceinline__ void combine_phase(const float* part, const float* lsebuf, bf16_t* y, int wv) {
    const int tid = opaque_tid(wv);
    for (int idx = blockIdx.x * NTHREADS + tid; idx < T * 96; idx += gridDim.x * NTHREADS) {
        const int tok = idx / 96, c8 = idx % 96, h = c8 >> 4, col = c8 * 8;
        const float l0 = lsebuf[(size_t)tok * 6 + h], l1 = lsebuf[(size_t)T * 6 + (size_t)tok * 6 + h], l2 = lsebuf[(size_t)2 * T * 6 + (size_t)tok * 6 + h];
        const float m = fmaxf(l0, fmaxf(l1, l2));
        float w0 = __expf(l0 - m), w1 = __expf(l1 - m), w2 = __expf(l2 - m); const float inv = 1.0f / (w0 + w1 + w2); w0 *= inv; w1 *= inv; w2 *= inv;
        const float* p0 = part + (size_t)tok * 768 + col; const float* p1 = p0 + (size_t)T * 768; const float* p2 = p1 + (size_t)T * 768;
        const f32x4 a0 = *(const f32x4*)p0, a1 = *(const f32x4*)(p0 + 4), b0 = *(const f32x4*)p1, b1 = *(const f32x4*)(p1 + 4), c0 = *(const f32x4*)p2, c1 = *(const f32x4*)(p2 + 4);
        const f32x4 v0 = a0 * w0 + b0 * w1 + c0 * w2, v1 = a1 * w0 + b1 * w1 + c1 * w2;
        u32x4 w; w.x = pk2(v0[0], v0[1]); w.y = pk2(v0[2], v0[3]); w.z = pk2(v1[0], v1[1]); w.w = pk2(v1[2], v1[3]);
        *(u32x4*)(y + (size_t)tok * DM + YA + col) = w;
    }
}

#define XB_TMO      128
#define XB_XCNT(j)  (256  + 64 * (j))
#define XB_XSUB(j)  (1280 + 64 * (j))
#define XB_XGEN(j)  (2304 + 64 * (j))
#define XB_TOP      3328
#define XB_TOPGEN   3392
#define XCD_BAR_WORDS 3456
#define XB_SPIN_CAP (1u << 18)

__device__ __forceinline__ unsigned xb_ld(unsigned* p)              { return __hip_atomic_load(p, __ATOMIC_RELAXED, __HIP_MEMORY_SCOPE_AGENT); }
__device__ __forceinline__ unsigned xb_add(unsigned* p, unsigned v) { return __hip_atomic_fetch_add(p, v, __ATOMIC_RELAXED, __HIP_MEMORY_SCOPE_AGENT); }
__device__ __forceinline__ unsigned xb_xcc_id() { return (unsigned)__builtin_amdgcn_s_getreg((3 << 11) | 20) & 0xFu; }
#define XB_SPIN(cond, bar) do { unsigned _sp = 0; while (cond) { __builtin_amdgcn_s_sleep(1); \
    if ((++_sp & 255u) == 0u) { if (xb_ld(&(bar)[XB_TMO])) break; if (_sp > XB_SPIN_CAP) { atomicAdd(&(bar)[XB_TMO], 1u); break; } } } } while (0)

struct XcdBarrier {
    int wv;
    unsigned* bar; unsigned x;
    volatile LAS unsigned* st;
};

__device__ __forceinline__ XcdBarrier xcd_barrier_post(unsigned* bar, volatile LAS unsigned* st, int wv) {
    XcdBarrier b; b.wv = wv; b.bar = bar; b.x = xb_xcc_id(); b.st = st;
    if (wv == 0 && lane_now() == 0) (void)xb_add(&bar[XB_XCNT(b.x)], 1u);
    return b;
}
__device__ __forceinline__ void xcd_barrier_complete(unsigned* bar, unsigned x, unsigned& nloc, unsigned& nx) {
    const unsigned G = gridDim.x * gridDim.y * gridDim.z;
    unsigned sum, cnt, mine, sp = 0u;
    for (;;) {
        sum = 0u; cnt = 0u; mine = 0u;
#pragma unroll
        for (unsigned j = 0; j < 16; ++j) { const unsigned c = xb_ld(&bar[XB_XCNT(j)]); sum += c; cnt += (c > 0u) ? 1u : 0u; mine = (j == x) ? c : mine; }
        if (sum == G) break;
        __builtin_amdgcn_s_sleep(1);
        if ((++sp & 255u) == 0u) { if (xb_ld(&bar[XB_TMO])) break; if (sp > XB_SPIN_CAP) { atomicAdd(&bar[XB_TMO], 1u); break; } }
    }
    nloc = mine > 0u ? mine : 1u; nx = cnt > 0u ? cnt : 1u;
}

__device__ __forceinline__ void xcd_barrier(const XcdBarrier& b) {
    asm volatile("s_waitcnt vmcnt(0)" ::: "memory");
    __syncthreads();
    if (b.wv == 0 && lane_now() == 0) {
        unsigned* bar = b.bar;
        __builtin_amdgcn_s_waitcnt(0);
        unsigned nloc = b.st[0], nx = b.st[1];
        if (nloc == 0u) { xcd_barrier_complete(bar, b.x, nloc, nx); b.st[0] = nloc; b.st[1] = nx; }
        const unsigned old = xb_add(&bar[XB_XSUB(b.x)], 1u);
        const unsigned gen = old / nloc;
        if (old + 1u == (gen + 1u) * nloc) {
            __builtin_amdgcn_fence(__ATOMIC_RELEASE, "agent");
            asm volatile("s_waitcnt vmcnt(0)" ::: "memory");
            const unsigned og = xb_add(&bar[XB_TOP], 1u);
            const unsigned tg = og / nx;
            if (og + 1u == (tg + 1u) * nx) xb_add(&bar[XB_TOPGEN], 1u);
            else XB_SPIN(xb_ld(&bar[XB_TOPGEN]) == tg, bar);
            __builtin_amdgcn_fence(__ATOMIC_ACQUIRE, "agent");
            xb_add(&bar[XB_XGEN(b.x)], 1u);
            asm volatile("s_waitcnt vmcnt(0)" ::: "memory");
        } else {
            XB_SPIN(xb_ld(&bar[XB_XGEN(b.x)]) == gen, bar);
            __builtin_amdgcn_fence(__ATOMIC_ACQUIRE, "agent");
            asm volatile("s_waitcnt vmcnt(0)" ::: "memory");
        }
    }
    __syncthreads();
}

constexpr int I_G = (DM / 64) * (DFF / 64), I_D = (DFF / 64) * (DM / 64), I_IN = (DM / 64) * (INW / 64), I_OUT = (DM / 64) * (DM / 64);
constexpr int PER_LAYER = 4 * I_G + 2 * I_D + I_IN + I_OUT, N_ITEMS = DEPTH * PER_LAYER;
constexpr int CV_P0 = 2 * I_G + I_D, CV_T1 = CV_P0 + 6400, CV_T2 = CV_T1 + 5120, CV_T3 = CV_T2 + 6400, CV_T4 = CV_T3 + 6400, CV_T5 = CV_T4 + 5120, CV_T6 = N_ITEMS;
constexpr int CW_F1 = 2 * I_G + I_D, CW_IN = CW_F1 + I_IN, CW_OUT = CW_IN + I_OUT, CW_F2GU = CW_OUT + 2 * I_G, CW_F2D = CW_F2GU + I_D;
static_assert(CW_F2D == PER_LAYER && CV_P0 >= CW_F1 && CV_T1 >= CW_IN && CV_T2 >= CW_F2GU && CV_T3 >= PER_LAYER + 2 * I_G && CV_T4 >= PER_LAYER + CW_IN && CV_T5 >= PER_LAYER + CW_F2GU && CV_T5 <= N_ITEMS && CV_T6 == N_ITEMS,
              "conversion slots: every weight is converted in a slot that ends before the phase that first reads it");
__device__ __forceinline__ TItem decode_item(const Args& a, unsigned char* ws, int it) {
    TItem t; const int l = it / PER_LAYER; int r = it % PER_LAYER;
    const size_t ogu = (size_t)l * DM * DFF;
    if (r < 2 * I_G + I_D) {
        t.g = a.in[1] + l * DM;
        if (r < I_G) { t.W = a.in[2] + ogu; t.K = DM; t.N = DFF; t.WT = (bf16_t*)(ws + WS_WGU + (size_t)(2 * l) * SZ_WGU); t.mode = 1; }
        else if (r < 2 * I_G) { r -= I_G; t.W = a.in[3] + ogu; t.K = DM; t.N = DFF; t.WT = (bf16_t*)(ws + WS_WGU + (size_t)(2 * l) * SZ_WGU); t.mode = 2; }
        else { r -= 2 * I_G; t.W = a.in[4] + ogu; t.K = DFF; t.N = DM; t.WT = (bf16_t*)(ws + WS_WD + (size_t)(2 * l) * SZ_WD); t.mode = 0; t.g = nullptr; }
    } else if (r < 2 * I_G + I_D + I_IN) { r -= 2 * I_G + I_D; t.W = a.in[6] + (size_t)l * DM * INW; t.K = DM; t.N = INW; t.g = a.in[5] + l * DM; t.WT = (bf16_t*)(ws + WS_WIN + (size_t)l * SZ_WIN); t.mode = 0; }
    else if (r < 2 * I_G + I_D + I_IN + I_OUT) { r -= 2 * I_G + I_D + I_IN; t.W = a.in[7] + (size_t)l * DM * DM; t.K = DM; t.N = DM; t.g = nullptr; t.WT = (bf16_t*)(ws + WS_WOUT + (size_t)l * SZ_WOUT); t.mode = 0; }
    else {
        r -= 2 * I_G + I_D + I_IN + I_OUT; t.g = a.in[14] + l * DM;
        if (r < I_G) { t.W = a.in[15] + ogu; t.K = DM; t.N = DFF; t.WT = (bf16_t*)(ws + WS_WGU + (size_t)(2 * l + 1) * SZ_WGU); t.mode = 1; }
        else if (r < 2 * I_G) { r -= I_G; t.W = a.in[16] + ogu; t.K = DM; t.N = DFF; t.WT = (bf16_t*)(ws + WS_WGU + (size_t)(2 * l + 1) * SZ_WGU); t.mode = 2; }
        else { r -= 2 * I_G; t.W = a.in[17] + ogu; t.K = DFF; t.N = DM; t.WT = (bf16_t*)(ws + WS_WD + (size_t)(2 * l + 1) * SZ_WD); t.mode = 0; t.g = nullptr; }
    }
    t.r = r; return t;
}
__device__ __forceinline__ void convert_range(const Args& a, unsigned char* ws, int begin, int end, int widx, int nworkers, LAS unsigned char* lds, int wv) {
    const int lane = lane_now();
    LAS unsigned char* scr = lds + wv * 9216;
    for (int it = begin + widx; it < end; it += 2 * nworkers) {
        const int it2 = it + nworkers; const bool two = it2 < end;
        const TItem t0 = decode_item(a, ws, it), t1 = decode_item(a, ws, two ? it2 : it);
        float v0[64], v1[64];
        titem_load(t0, lane, v0);
        if (two) titem_load(t1, lane, v1);
        titem_store(t0, lane, v0, scr);
        if (two) titem_store(t1, lane, v1, scr);
    }
}
__device__ __forceinline__ void tail_convert(const Args& a, unsigned char* ws, int nwg, int begin, int end, int wv, LAS unsigned char* lds) {
    const int G = gridDim.x, c = blockIdx.x, rounds = (nwg + G - 1) / G, nb = nwg - (rounds - 1) * G, wave = wv;
    if (nb >= G) convert_range(a, ws, begin, end, c * NWAVES + wave, G * NWAVES, lds, wv);
    else if (c >= nb) convert_range(a, ws, begin, end, (c - nb) * NWAVES + wave, (G - nb) * NWAVES, lds, wv);
}

__global__ void __launch_bounds__(NTHREADS, 2) fwd_kernel(Args a) {
    extern __shared__ __attribute__((aligned(16))) unsigned char lds_raw[];
    LAS unsigned char* lds = (LAS unsigned char*)lds_raw;
    cg::grid_group grid = cg::this_grid();
    const int tid = threadIdx.x, lane = tid & 63, wave = tid >> 6;
    const int wv = __builtin_amdgcn_readfirstlane(tid >> 6);
    const int gw = blockIdx.x * NWAVES + wave, NGW = gridDim.x * NWAVES;
    unsigned char* ws = a.ws;
    float* SS = (float*)(ws + WS_SS);
    bf16_t* XB = (bf16_t*)(ws + WS_XB);
    bf16_t* ACT = (bf16_t*)(ws + WS_ACT);
    bf16_t* QKV = (bf16_t*)(ws + WS_QKV);
    bf16_t* Y = (bf16_t*)(ws + WS_Y);
    float* PART = (float*)(ws + WS_PART); float* LSE = (float*)(ws + WS_LSE);
    float* XO = a.out;
    unsigned* BARW = (unsigned*)(ws + WS_BAR);
    volatile LAS unsigned* bar_st = (volatile LAS unsigned*)(lds + 131072 + 352);
    if (tid < 2) bar_st[tid] = 0u;
    __syncthreads();
    const XcdBarrier xbar = xcd_barrier_post(BARW, bar_st, wv);
    if (a.ws == nullptr) grid.sync();

    for (int rep = 0; rep <= PROBE_PRO; ++rep) {
        for (int i = blockIdx.x * NTHREADS + tid; i < 6 * T; i += gridDim.x * NTHREADS) SS[T + i] = 0.f;
        const float* x = a.in[0];
        for (int m = gw; m < T; m += NGW) {
            const f32x4* xr = (const f32x4*)(x + (size_t)m * DM) + lane; float s = 0.f;
            unsigned long long* o8 = (unsigned long long*)(XB + (size_t)m * DM) + lane;
#pragma unroll
            for (int j = 0; j < 8; ++j) { const f32x4 v = xr[64 * j]; s += (v.x * v.x + v.y * v.y) + (v.z * v.z + v.w * v.w);
                o8[64 * j] = (unsigned long long)pk2(v.x, v.y) | ((unsigned long long)pk2(v.z, v.w) << 32); }
            s = wave_sum(s);
            if (lane == 0) SS[m] = s;
        }
        convert_range(a, ws, 0, CV_P0, gw, NGW, lds, wv);
    }
    xcd_barrier(xbar);
    for (int rep = 0; rep < PROBE_SYNC; ++rep) xcd_barrier(xbar);

    for (int l = 0; l < DEPTH; ++l) {
        bf16_t* wgu1 = (bf16_t*)(ws + WS_WGU + (size_t)(2 * l + 0) * SZ_WGU); bf16_t* wgu2 = (bf16_t*)(ws + WS_WGU + (size_t)(2 * l + 1) * SZ_WGU);
        bf16_t* wd1 = (bf16_t*)(ws + WS_WD + (size_t)(2 * l + 0) * SZ_WD); bf16_t* wd2 = (bf16_t*)(ws + WS_WD + (size_t)(2 * l + 1) * SZ_WD);
        bf16_t* win = (bf16_t*)(ws + WS_WIN + (size_t)l * SZ_WIN); bf16_t* wout = (bf16_t*)(ws + WS_WOUT + (size_t)l * SZ_WOUT);
        float* ss0 = SS + (size_t)(3 * l + 0) * T; float* ss1 = SS + (size_t)(3 * l + 1) * T; float* ss2 = SS + (size_t)(3 * l + 2) * T; float* ss3 = SS + (size_t)(3 * l + 3) * T;
        const float* xin = (l == 0) ? a.in[0] : XO;
        for (int rep = 0; rep <= PROBE_GU; ++rep)
        { pg8::Gemm g{XB, wgu1, T, NGU, DM}; pg8::StaticOrder S; S.init(T, NGU, (int)gridDim.x, opaque_bid()); pg8::EpiGU E{ACT, ss0};
          pg8::gemm_phase<pg8::EpiGU, pg8::StaticOrder, true, true>(lds, g, S, E, wv); }
        if (l == 0) tail_convert(a, ws, (T / 256) * (NGU / 256), CV_P0, CV_T1, wv, lds); else tail_convert(a, ws, (T / 256) * (NGU / 256), CV_T3, CV_T4, wv, lds);
        xcd_barrier(xbar);
        { pg8::Gemm g{ACT, wd1, T, DM, DFF}; pg8::StaticOrder S; S.init(T, DM, (int)gridDim.x, opaque_bid()); pg8::EpiResid E{xin, XO, XB, ss1, 0.5f};
          pg8::gemm_phase<pg8::EpiResid, pg8::StaticOrder, true, true>(lds, g, S, E, wv); }
        xcd_barrier(xbar);
        { pg8::Gemm g{XB, win, T, INW, DM}; pg8::StaticOrder S; S.init(T, INW, (int)gridDim.x, opaque_bid()); pg8::EpiRow E{QKV, INW, ss1};
          pg8::gemm_phase<pg8::EpiRow, pg8::StaticOrder, true, true>(lds, g, S, E, wv); }
        if (l == 0) tail_convert(a, ws, (T / 256) * (INW / 256), CV_T1, CV_T2, wv, lds); else tail_convert(a, ws, (T / 256) * (INW / 256), CV_T4, CV_T5, wv, lds);
        xcd_barrier(xbar);
        for (int rep = 0; rep <= PROBE_ATTN; ++rep)
        attn_mfma_phase<MFMA_B, MFMA_A, MFMA_C>(a, l, QKV, Y, PART, LSE, (char*)lds_raw, wv);
        if (!(MFMA_B && MFMA_A && MFMA_C)) { __syncthreads(); attn_naive_phase<!MFMA_B, !MFMA_A, !MFMA_C>(a, l, QKV, Y, lds); }
        xcd_barrier(xbar);
        if (MFMA_A) { combine_phase(PART, LSE, Y, wv); xcd_barrier(xbar); }
        { pg8::Gemm g{Y, wout, T, DM, DM}; pg8::StaticOrder S; S.init(T, DM, (int)gridDim.x, opaque_bid()); pg8::EpiResid E{XO, XO, XB, ss2, 1.0f};
          pg8::gemm_phase<pg8::EpiResid, pg8::StaticOrder, true, true>(lds, g, S, E, wv); }
        xcd_barrier(xbar);
        { pg8::Gemm g{XB, wgu2, T, NGU, DM}; pg8::StaticOrder S; S.init(T, NGU, (int)gridDim.x, opaque_bid()); pg8::EpiGU E{ACT, ss2};
          pg8::gemm_phase<pg8::EpiGU, pg8::StaticOrder, true, true>(lds, g, S, E, wv); }
        if (l == 0) tail_convert(a, ws, (T / 256) * (NGU / 256), CV_T2, CV_T3, wv, lds); else tail_convert(a, ws, (T / 256) * (NGU / 256), CV_T5, CV_T6, wv, lds);
        xcd_barrier(xbar);
        { pg8::Gemm g{ACT, wd2, T, DM, DFF}; pg8::StaticOrder S; S.init(T, DM, (int)gridDim.x, opaque_bid()); pg8::EpiResid E{XO, XO, XB, ss3, 0.5f};
          pg8::gemm_phase<pg8::EpiResid, pg8::StaticOrder, true, true>(lds, g, S, E, wv); }
        xcd_barrier(xbar);
    }
    {
        const float* ssf = SS + (size_t)6 * T; const float* g = a.in[18];
        const int lane = lane_now(), gw = blockIdx.x * NWAVES + wv;
        for (int m = gw; m < T; m += NGW) {
            const float rs = rstd_of(ssf, m);
            f32x4* xr = (f32x4*)(XO + (size_t)m * DM) + lane; const f32x4* gr = (const f32x4*)g + lane;
#pragma unroll
            for (int j = 0; j < 8; ++j) { f32x4 v = xr[64 * j]; const f32x4 gg = gr[64 * j]; v = v * rs * gg; xr[64 * j] = v; }
        }
    }
}

extern "C" void kernel_launch(void* const* d_in, const int* in_sizes, int n_in, void* d_out, int out_size, void* d_ws, size_t ws_size, hipStream_t stream) {
    static int grid = 0;
    if (grid == 0) {
        if (n_in != 19 || out_size != T * DM || ws_size < WS_END) { fprintf(stderr, "kernel_launch: unexpected shapes n_in %d out %d ws %zu (need %zu)\n", n_in, out_size, ws_size, (size_t)WS_END); grid = -1; return; }
        int dev = 0, cus = 0, per_cu = 0;
        hipGetDevice(&dev);
        hipDeviceGetAttribute(&cus, hipDeviceAttributeMultiprocessorCount, dev);
        if (hipFuncSetAttribute((const void*)fwd_kernel, hipFuncAttributeMaxDynamicSharedMemorySize, LDS_BYTES) != hipSuccess) { fprintf(stderr, "kernel_launch: hipFuncSetAttribute failed\n"); grid = -1; return; }
        if (hipOccupancyMaxActiveBlocksPerMultiprocessor(&per_cu, (const void*)fwd_kernel, NTHREADS, LDS_BYTES) != hipSuccess || per_cu < 1) { fprintf(stderr, "kernel_launch: occupancy query gave %d\n", per_cu); per_cu = 1; }
        (void)hipGetLastError();
        grid = cus * per_cu;
        fprintf(stderr, "kernel_launch: grid %d (cus %d x %d)\n", grid, cus, per_cu);
    }
    if (grid < 0) return;
    if (hipMemsetAsync((char*)d_ws + WS_BAR, 0, 16384, stream) != hipSuccess) { fprintf(stderr, "kernel_launch: hipMemsetAsync of the barrier words failed\n"); return; }
    Args a{};
    for (int i = 0; i < 19; ++i) a.in[i] = (const float*)d_in[i];
    a.out = (float*)d_out; a.ws = (unsigned char*)d_ws;
    void* args[] = {&a};
    hipError_t e = hipLaunchCooperativeKernel((const void*)fwd_kernel, dim3(grid), dim3(NTHREADS), args, LDS_BYTES, stream);
    if (e != hipSuccess) fprintf(stderr, "kernel_launch: cooperative launch failed: %s (grid %d)\n", hipGetErrorString(e), grid);
}
```
